# Optimizing an MI355X kernel written in HIP

```python
import math
import jax, jax.numpy as jnp
from jax import lax
import numpy as np

D_MODEL = 1024
BATCH = 8
SEQ = 8192
DEPTH = 2
DEC_BATCH = 4
DEC_SEQ = 4096
PAST_LEN = 128

GRID_W = 64
Q_BLOCK = 128
ROPE_THETA = 10000.0
EPS = 1e-6

D_FF = 2816

N_BRANCH = 3
BRANCH_W = 512

GQA_HEADS = 8
GQA_KV_HEADS = 2
GQA_GROUPS = GQA_HEADS // GQA_KV_HEADS
GQA_HEAD_DIM = 64

HY_WIDTH = 512
HY_ORDER = 64
HY_EMB = 33
HY_BANDS = (HY_EMB - 1) // 2
HY_TARGET = 1e-2
HY_FAST = 0.3
HY_SLOW = 1.5
HY_SHORT = 3

MLA_HEADS = 8
MLA_Q_RANK = 256
MLA_KV_RANK = 128
MLA_NOPE = 64
MLA_ROPE = 32
MLA_V = 64

IN_WIDTHS = (
    GQA_HEADS * GQA_HEAD_DIM,
    GQA_KV_HEADS * GQA_HEAD_DIM,
    GQA_KV_HEADS * GQA_HEAD_DIM,
    3 * HY_WIDTH,
    MLA_Q_RANK,
    MLA_KV_RANK,
    MLA_ROPE,
    N_BRANCH * D_MODEL,
)
IN_WIDTH = sum(IN_WIDTHS)
IN_SPLITS = tuple(int(c) for c in np.cumsum(IN_WIDTHS)[:-1])

kernel_name = "hybrid_gqa_hyena_mla_macaron_encoder"


def rmsnorm(x, g):
    x32 = x.astype(jnp.float32)
    y = x32 * lax.rsqrt(jnp.mean(x32 * x32, axis=-1, keepdims=True) + EPS)
    return (y * g.astype(jnp.float32)).astype(x.dtype)


def swiglu(x, w_gate, w_up, w_down):
    return (jax.nn.silu(x @ w_gate) * (x @ w_up)) @ w_down


def axial_rope(L, d_rot):
    rows = L // GRID_W
    row = jnp.repeat(jnp.arange(rows, dtype=jnp.float32), GRID_W)
    col = jnp.tile(jnp.arange(GRID_W, dtype=jnp.float32), rows)
    n_freq = d_rot // 4
    inv = ROPE_THETA ** (-jnp.arange(n_freq, dtype=jnp.float32) / n_freq)
    ang = jnp.concatenate([row[:, None] * inv, col[:, None] * inv], axis=-1)
    return jnp.cos(ang), jnp.sin(ang)


def apply_rope(x, cos, sin):
    xp = x.reshape(x.shape[:-1] + (-1, 2))
    x0, x1 = xp[..., 0], xp[..., 1]
    c = cos[None, :, None, :].astype(x.dtype)
    s = sin[None, :, None, :].astype(x.dtype)
    return jnp.stack([x0 * c - x1 * s, x0 * s + x1 * c], axis=-1).reshape(x.shape)


def block_attention(q, k, v, scale):
    B, L, Hk, G, dk = q.shape
    dv = v.shape[-1]
    nb = L // Q_BLOCK
    qb = jnp.moveaxis(q.reshape(B, nb, Q_BLOCK, Hk, G, dk), 1, 0)

    def attend(qblk):
        s = jnp.einsum("bqkgd,bskd->bkgqs", qblk, k,
                       preferred_element_type=jnp.float32) * scale
        p = jax.nn.softmax(s, axis=-1).astype(v.dtype)
        return jnp.einsum("bkgqs,bskd->bqkgd", p, v)

    o = lax.map(attend, qb)
    return jnp.moveaxis(o, 0, 1).reshape(B, L, Hk, G, dv)


def gqa_branch(q, k, v, g_q, g_k, cos, sin):
    B, L, _ = q.shape
    q = apply_rope(rmsnorm(q.reshape(B, L, GQA_HEADS, GQA_HEAD_DIM), g_q), cos, sin)
    k = apply_rope(rmsnorm(k.reshape(B, L, GQA_KV_HEADS, GQA_HEAD_DIM), g_k), cos, sin)
    v = v.reshape(B, L, GQA_KV_HEADS, GQA_HEAD_DIM)
    q = q.reshape(B, L, GQA_KV_HEADS, GQA_GROUPS, GQA_HEAD_DIM)
    o = block_attention(q, k, v, GQA_HEAD_DIM ** -0.5)
    return o.reshape(B, L, GQA_HEADS * GQA_HEAD_DIM)


def hyena_positions(L):
    t = jnp.linspace(0.0, 1.0, L, dtype=jnp.float32)[:, None]
    w = 2.0 * math.pi * jnp.arange(L, dtype=jnp.float32)[:, None] / L
    f = jnp.linspace(1e-4, HY_BANDS - 1, HY_BANDS, dtype=jnp.float32)[None, :]
    z = jnp.concatenate([t, jnp.cos(f * w), -jnp.sin(f * w)], axis=-1)
    max_decay = math.log(HY_TARGET) / HY_FAST
    min_decay = math.log(HY_TARGET) / HY_SLOW
    deltas = jnp.abs(jnp.linspace(min_decay, max_decay, HY_WIDTH, dtype=jnp.float32))
    window = jnp.exp(-t * deltas[None, :])
    return z, window


def hyena_filter(z, window, w1, b1, w2, b2, w3, freq):
    f32 = jnp.float32
    fr = freq.astype(f32)
    h = jnp.sin(fr * (z @ w1.astype(f32) + b1.astype(f32)))
    h = jnp.sin(fr * (h @ w2.astype(f32) + b2.astype(f32)))
    h = (h @ w3.astype(f32)).reshape(-1, 2, HY_WIDTH) * window[:, None, :]
    fwd, bwd = h[:, 0], h[:, 1]
    return jnp.concatenate([fwd, jnp.zeros((1, HY_WIDTH), f32), bwd[:0:-1]], axis=0)


def hyena_branch(hy, z_pos, window, w_short, b_short, w1, b1, w2, b2, w3, freq, bias):
    B, L, _ = hy.shape
    hp = jnp.pad(hy, ((0, 0), (1, 1), (0, 0)))
    hy = hp[:, :-2] * w_short[0] + hp[:, 1:-1] * w_short[1] + hp[:, 2:] * w_short[2] + b_short
    x0, x1, v = jnp.split(hy, 3, axis=-1)
    kc = hyena_filter(z_pos, window, w1, b1, w2, b2, w3, freq)
    s = (x1 * v).astype(jnp.float32)
    spec = jnp.fft.rfft(s, n=2 * L, axis=1) * jnp.fft.rfft(kc, axis=0)[None]
    y = jnp.fft.irfft(spec, n=2 * L, axis=1)[:, :L] + s * bias.astype(jnp.float32)
    return (x0.astype(jnp.float32) * y).astype(hy.dtype)


def mla_branch(cq, ckv, kr, g_q, w_uq, g_kv, w_ukv, cos, sin):
    B, L, _ = cq.shape
    qh = (rmsnorm(cq, g_q) @ w_uq).reshape(B, L, MLA_HEADS, MLA_NOPE + MLA_ROPE)
    q_nope, q_rope = qh[..., :MLA_NOPE], qh[..., MLA_NOPE:]
    q_rope = apply_rope(q_rope, cos, sin)
    kvh = (rmsnorm(ckv, g_kv) @ w_ukv).reshape(B, L, MLA_HEADS, MLA_NOPE + MLA_V)
    k_nope, vh = kvh[..., :MLA_NOPE], kvh[..., MLA_NOPE:]
    k_rope = apply_rope(kr.reshape(B, L, 1, MLA_ROPE), cos, sin)
    qf = jnp.concatenate([q_nope, q_rope], axis=-1)[:, :, :, None, :]
    kf = jnp.concatenate([k_nope, jnp.broadcast_to(k_rope, (B, L, MLA_HEADS, MLA_ROPE))], axis=-1)
    o = block_attention(qf, kf, vh, (MLA_NOPE + MLA_ROPE) ** -0.5)
    return o.reshape(B, L, MLA_HEADS * MLA_V)


def encoder(x, params):
    (g_ffn1, w_ffn1_gate, w_ffn1_up, w_ffn1_down, g_mix, w_in, g_qnorm, g_knorm,
     w_hy_short, b_hy_short, w_hy_f1, b_hy_f1, w_hy_f2, b_hy_f2, w_hy_f3, hy_sin_freq, hy_bias,
     g_mla_q, w_mla_uq, g_mla_kv, w_mla_ukv, w_branch, w_out,
     g_ffn2, w_ffn2_gate, w_ffn2_up, w_ffn2_down, g_final) = params
    B, L, _ = x.shape
    cos_a, sin_a = axial_rope(L, GQA_HEAD_DIM)
    cos_m, sin_m = axial_rope(L, MLA_ROPE)
    z_pos, window = hyena_positions(L)
    for l in range(DEPTH):
        x = x + 0.5 * swiglu(rmsnorm(x, g_ffn1[l]), w_ffn1_gate[l], w_ffn1_up[l], w_ffn1_down[l])
        u = rmsnorm(x, g_mix[l])
        zc = u @ w_in[l]
        q, k, v, hy, cq, ckv, kr, gl = jnp.split(zc, IN_SPLITS, axis=-1)
        y_a = gqa_branch(q, k, v, g_qnorm[l], g_knorm[l], cos_a, sin_a)
        y_b = hyena_branch(hy, z_pos, window, w_hy_short[l], b_hy_short[l], w_hy_f1[l], b_hy_f1[l],
                           w_hy_f2[l], b_hy_f2[l], w_hy_f3[l], hy_sin_freq[l], hy_bias[l])
        y_c = mla_branch(cq, ckv, kr, g_mla_q[l], w_mla_uq[l], g_mla_kv[l], w_mla_ukv[l], cos_m, sin_m)
        gates = jax.nn.sigmoid(gl.reshape(B, L, N_BRANCH, D_MODEL))
        merged = (gates[:, :, 0] * (y_a @ w_branch[l, 0])
                  + gates[:, :, 1] * (y_b @ w_branch[l, 1])
                  + gates[:, :, 2] * (y_c @ w_branch[l, 2]))
        x = x + merged @ w_out[l]
        x = x + 0.5 * swiglu(rmsnorm(x, g_ffn2[l]), w_ffn2_gate[l], w_ffn2_up[l], w_ffn2_down[l])
    return rmsnorm(x, g_final)


def setup_inputs(seed: int = 0) -> dict:
    key = jax.random.key(seed)
    ks = jax.random.split(key, 40)
    cnt = [0]

    def nxt():
        cnt[0] += 1
        return ks[cnt[0] - 1]

    def nrm(shape, scale):
        return scale * jax.random.normal(nxt(), shape, jnp.float32)

    def gain(shape):
        return 1.0 + 0.01 * jax.random.normal(nxt(), shape, jnp.float32)

    D = D_MODEL
    return {
        "x_prompt": nrm((BATCH, SEQ, D), 1.0),
        "x_sample": nrm((DEC_BATCH, DEC_SEQ, D), 1.0),
        "g_ffn1": gain((DEPTH, D)),
        "w_ffn1_gate": nrm((DEPTH, D, D_FF), D ** -0.5),
        "w_ffn1_up": nrm((DEPTH, D, D_FF), D ** -0.5),
        "w_ffn1_down": nrm((DEPTH, D_FF, D), D_FF ** -0.5),
        "g_mix": gain((DEPTH, D)),
        "w_in": nrm((DEPTH, D, IN_WIDTH), D ** -0.5),
        "g_qnorm": gain((DEPTH, GQA_HEAD_DIM)),
        "g_knorm": gain((DEPTH, GQA_HEAD_DIM)),
        "w_hy_short": nrm((DEPTH, HY_SHORT, 3 * HY_WIDTH), HY_SHORT ** -0.5),
        "b_hy_short": nrm((DEPTH, 3 * HY_WIDTH), 0.02),
        "w_hy_f1": nrm((DEPTH, HY_EMB, HY_ORDER), HY_EMB ** -0.5),
        "b_hy_f1": nrm((DEPTH, HY_ORDER), 0.02),
        "w_hy_f2": nrm((DEPTH, HY_ORDER, HY_ORDER), HY_ORDER ** -0.5),
        "b_hy_f2": nrm((DEPTH, HY_ORDER), 0.02),
        "w_hy_f3": nrm((DEPTH, HY_ORDER, 2 * HY_WIDTH), 0.02),
        "hy_sin_freq": gain((DEPTH, HY_ORDER)),
        "hy_bias": nrm((DEPTH, HY_WIDTH), 0.5),
        "g_mla_q": gain((DEPTH, MLA_Q_RANK)),
        "w_mla_uq": nrm((DEPTH, MLA_Q_RANK, MLA_HEADS * (MLA_NOPE + MLA_ROPE)), MLA_Q_RANK ** -0.5),
        "g_mla_kv": gain((DEPTH, MLA_KV_RANK)),
        "w_mla_ukv": nrm((DEPTH, MLA_KV_RANK, MLA_HEADS * (MLA_NOPE + MLA_V)), MLA_KV_RANK ** -0.5),
        "w_branch": nrm((DEPTH, N_BRANCH, BRANCH_W, D), BRANCH_W ** -0.5),
        "w_out": nrm((DEPTH, D, D), D ** -0.5),
        "g_ffn2": gain((DEPTH, D)),
        "w_ffn2_gate": nrm((DEPTH, D, D_FF), D ** -0.5),
        "w_ffn2_up": nrm((DEPTH, D, D_FF), D ** -0.5),
        "w_ffn2_down": nrm((DEPTH, D_FF, D), D_FF ** -0.5),
        "g_final": gain((D,)),
    }


def reference(x_prompt, x_sample, g_ffn1, w_ffn1_gate, w_ffn1_up, w_ffn1_down, g_mix, w_in,
              g_qnorm, g_knorm, w_hy_short, b_hy_short, w_hy_f1, b_hy_f1, w_hy_f2, b_hy_f2,
              w_hy_f3, hy_sin_freq, hy_bias, g_mla_q, w_mla_uq, g_mla_kv, w_mla_ukv,
              w_branch, w_out, g_ffn2, w_ffn2_gate, w_ffn2_up, w_ffn2_down, g_final):
    params = (g_ffn1, w_ffn1_gate, w_ffn1_up, w_ffn1_down, g_mix, w_in, g_qnorm, g_knorm,
              w_hy_short, b_hy_short, w_hy_f1, b_hy_f1, w_hy_f2, b_hy_f2, w_hy_f3, hy_sin_freq,
              hy_bias, g_mla_q, w_mla_uq, g_mla_kv, w_mla_ukv, w_branch, w_out,
              g_ffn2, w_ffn2_gate, w_ffn2_up, w_ffn2_down, g_final)
    y_prompt = encoder(x_prompt, params)
    y_sample = encoder(x_sample, params)
    return (y_prompt, y_sample)
```

```cpp
#include <hip/hip_runtime.h>
#include <hip/hip_bf16.h>
#include <hip/hip_cooperative_groups.h>
#include <cstdio>
#include <cstdint>
namespace cg = cooperative_groups;

#define LAS __attribute__((address_space(3)))
typedef unsigned short bf16_t;
typedef short bf16x8 __attribute__((ext_vector_type(8)));
typedef short s16x4 __attribute__((ext_vector_type(4)));
typedef float f32x4 __attribute__((ext_vector_type(4)));
typedef float f32x2 __attribute__((ext_vector_type(2)));
typedef float f32x16 __attribute__((ext_vector_type(16)));
typedef unsigned u32x4 __attribute__((ext_vector_type(4)));
typedef unsigned u32x2 __attribute__((ext_vector_type(2)));

constexpr int DM = 1024, DFF = 2816, MP = 65536, MS = 16384, MT = MP + MS;
constexpr int LP = 8192, LS = 4096;
constexpr int ZCW = 2816;
constexpr int C_Q = 0, C_K = 512, C_V = 640, C_HY = 768, C_CQ = 2304, C_CKV = 2560, C_KR = 2688;
constexpr int C_YB = 1280, C_YC = 1792;
constexpr float EPS = 1e-6f;
constexpr size_t MiB = 1u << 20;
constexpr size_t WS_T2 = 0, WS_TABA = 64 * 1024, WS_TABM = 80 * 1024, WS_H2 = 1 * MiB;
constexpr size_t WS_BAR = 7 * MiB;
constexpr size_t WS_W = 8 * MiB;
constexpr size_t WS_XN = 60 * MiB;
constexpr size_t WS_BIG = 220 * MiB;
constexpr size_t WS_R2 = 660 * MiB;
constexpr size_t WS_ST = WS_R2;
constexpr size_t WS_QH = WS_R2 + 80 * MiB;
constexpr size_t WS_KVH = WS_R2 + 200 * MiB;
constexpr size_t WS_MG = WS_R2;
constexpr size_t WS_PB = WS_R2 + 160 * MiB;
constexpr size_t WS_END = 1024 * MiB;
constexpr size_t WO_GU1 = 0, WO_DN1 = WO_GU1 + 5632 * 1024, WO_IN = WO_DN1 + 1024 * 2816, WO_GATE = WO_IN + 2816 * 1024, WO_UQ = WO_GATE + 3072 * 1024,
                 WO_UKV = WO_UQ + 768 * 256, WO_BR = WO_UKV + 1024 * 128, WO_OUT = WO_BR + 3 * 1024 * 512, WO_GU2 = WO_OUT + 1024 * 1024, WO_DN2 = WO_GU2 + 5632 * 1024,
                 WO_END = WO_DN2 + 1024 * 2816;
static_assert(WO_END * 2 + 5 * (size_t)MT * 4 <= 52 * MiB, "weights + row statistics fit");
constexpr int LDS_BYTES = 139264 + 2048;

__device__ __forceinline__ int fresh_lane() { int l; asm volatile("v_mbcnt_lo_u32_b32 %0, -1, 0\n\tv_mbcnt_hi_u32_b32 %0, -1, %0" : "=v"(l)); return l; }
__device__ __forceinline__ int fresh_tid(int wave) { return wave * 64 + fresh_lane(); }
__device__ __forceinline__ float bf2f(unsigned h) { return __uint_as_float(h << 16); }
__device__ __forceinline__ unsigned f2bf(float f) { unsigned u = __float_as_uint(f); return (u + 0x7fffu + ((u >> 16) & 1u)) >> 16; }
__device__ __forceinline__ unsigned pk2(float lo, float hi) { return f2bf(lo) | (f2bf(hi) << 16); }
typedef __bf16 bf16x2_t_ __attribute__((ext_vector_type(2)));
__device__ __forceinline__ unsigned cvt_pk_bf16(float lo, float hi) { f32x2 v = {lo, hi}; bf16x2_t_ b = __builtin_convertvector(v, bf16x2_t_); return __builtin_bit_cast(unsigned, b); }
__device__ __forceinline__ float shfl_xor_l(float v, int o, int lane) { return __int_as_float(__builtin_amdgcn_ds_bpermute((lane ^ o) << 2, __float_as_int(v))); }
__device__ __forceinline__ float bcast_l(float v, int src) { return __int_as_float(__builtin_amdgcn_readlane(__float_as_int(v), src)); }
__device__ __forceinline__ float wave_sum(float v, int lane) {
#pragma unroll
    for (int o = 1; o < 64; o <<= 1) v += shfl_xor_l(v, o, lane);
    return v;
}
__device__ __forceinline__ float sigmoidf_(float x) { return __builtin_amdgcn_rcpf(1.0f + __builtin_amdgcn_exp2f(-1.4426950408889634f * x)); }

namespace pg8 {
constexpr int BM = 256, BK = 64, HALF = 128, HTB = HALF * BK * 2, STAGE_BYTES = 8 * HTB, NXCD = 8, WGM = 8;
__host__ __device__ __forceinline__ int lds_byte(int r, int c) { const int st = (r >> 4) * 2 + (c >> 5), rr = r & 15, cc = c & 31, ob = rr * 64 + cc * 2; return st * 1024 + (ob ^ (((ob >> 9) & 1) << 5)); }
__host__ __device__ __forceinline__ void stage_rc(int b, int& R, int& C) { const int st = b / 1024, sb = b % 1024, swz = sb ^ (((sb >> 9) & 1) << 5); R = (st >> 1) * 16 + swz / 64; C = (st & 1) * 32 + (swz % 64) / 2; }
__host__ __device__ __forceinline__ int perm32(int rho) { const int n = rho >> 4, i = rho & 15; return 8 * (i >> 2) + 4 * n + (i & 3); }
struct Unit { int pm, pn; };
struct Gemm { const bf16_t* A; const bf16_t* Bt; int M, N, K, lda; };
struct StaticOrder {
    int nM, nN, nwg, G, c;
    __device__ void init(int M, int N, int G_, int c_) { nM = M / BM; nN = N / BM; nwg = nM * nN; G = G_; c = c_; }
    __device__ bool next(int i, Unit& u) const {
        const long L = (long)i * G + c; if (L >= nwg) return false;
        int wgid = (int)L; { const int q = nwg / NXCD, r = nwg % NXCD, xcd = wgid % NXCD, off = wgid / NXCD; wgid = (xcd < r ? xcd * (q + 1) : r * (q + 1) + (xcd - r) * q) + off; }
        const int nig = WGM * nN, gid = wgid / nig, fm = gid * WGM, gsz = (nM - fm) < WGM ? (nM - fm) : WGM;
        u.pm = fm + ((wgid % nig) % gsz); u.pn = (wgid % nig) / gsz; return true;
    }
};
typedef f32x4 Acc[2][2][4][2];

struct EpiStore {
    bf16_t* O; int ldc; const float* ss;
    __device__ __forceinline__ void operator()(const Acc& acc, const Unit& u, int wr, int wc, int fr, int fq) const {
        const int row0 = u.pm * BM + wr * 64 + fr, col0 = u.pn * BM + wc * 32 + 8 * fq;
#pragma unroll
        for (int ai = 0; ai < 2; ++ai)
#pragma unroll
            for (int m = 0; m < 4; ++m) { const int row = row0 + ai * HALF + m * 16; bf16_t* rowp = O + (size_t)row * ldc + col0;
                const float rs = ss ? 1.0f / sqrtf(((ss[row] + ss[MT + row]) + (ss[2 * MT + row] + ss[3 * MT + row])) * (1.f / DM) + EPS) : 1.f;
#pragma unroll
                for (int bj = 0; bj < 2; ++bj) { const f32x4 v0 = acc[ai][bj][m][0] * rs, v1 = acc[ai][bj][m][1] * rs;
                    u32x4 w; w.x = cvt_pk_bf16(v0[0], v0[1]); w.y = cvt_pk_bf16(v0[2], v0[3]); w.z = cvt_pk_bf16(v1[0], v1[1]); w.w = cvt_pk_bf16(v1[2], v1[3]);
                    *(u32x4*)(rowp + bj * HALF) = w; } }
    }
};
struct EpiSwiglu {
    bf16_t* O; int ldc; const float* ss;
    __device__ __forceinline__ void operator()(const Acc& acc, const Unit& u, int wr, int wc, int fr, int fq) const {
        const int row0 = u.pm * BM + wr * 64 + fr, col0 = u.pn * HALF + wc * 32 + 8 * fq;
#pragma unroll
        for (int ai = 0; ai < 2; ++ai)
#pragma unroll
            for (int m = 0; m < 4; ++m) { const int row = row0 + ai * HALF + m * 16; bf16_t* rowp = O + (size_t)row * ldc + col0;
                const float rs = ss ? 1.0f / sqrtf(((ss[row] + ss[MT + row]) + (ss[2 * MT + row] + ss[3 * MT + row])) * (1.f / DM) + EPS) : 1.f;
                float h[8];
#pragma unroll
                for (int n = 0; n < 2; ++n)
#pragma unroll
                    for (int j = 0; j < 4; ++j) { const float g = acc[ai][0][m][n][j] * rs, up = acc[ai][1][m][n][j] * rs; h[n * 4 + j] = g * sigmoidf_(g) * up; }
                u32x4 w; w.x = cvt_pk_bf16(h[0], h[1]); w.y = cvt_pk_bf16(h[2], h[3]); w.z = cvt_pk_bf16(h[4], h[5]); w.w = cvt_pk_bf16(h[6], h[7]);
                *(u32x4*)rowp = w; }
    }
};
template <int HALFA> struct EpiResid {
    float* X_; const float* gnext_; bf16_t* XNo_; float* ss_; LAS float* part_; const float* Rp_; const float* Rs_;
    __device__ __forceinline__ void operator()(const Acc& acc, const Unit& u, int wr, int wc, int fr, int fq) const {
        float* const X = X_; const float alpha = HALFA ? 0.5f : 1.0f; const float* const gnext = gnext_; bf16_t* const XNo = XNo_; float* const ss = ss_; LAS float* const part = part_;
        const float* const R = Rp_ ? (u.pm * BM < MP ? Rp_ : Rs_ - (size_t)MP * DM) : X;
        const int row0 = u.pm * BM + wr * 64 + fr, col0 = u.pn * BM + wc * 32 + 8 * fq; const int lane = fr + 16 * fq;
        f32x4 gv[2][2];
        if (gnext) {
#pragma unroll
            for (int bj = 0; bj < 2; ++bj)
#pragma unroll
                for (int n = 0; n < 2; ++n) gv[bj][n] = *(const f32x4*)(gnext + col0 + bj * HALF + 4 * n); }
#pragma unroll
        for (int ai = 0; ai < 2; ++ai)
#pragma unroll
            for (int m = 0; m < 4; ++m) { const int row = row0 + ai * HALF + m * 16; float* rowp = X + (size_t)row * DM + col0; float sq = 0.f;
#pragma unroll
                for (int bj = 0; bj < 2; ++bj) { f32x4* p0 = (f32x4*)(rowp + bj * HALF); const f32x4* r0 = (const f32x4*)(R + (size_t)row * DM + col0 + bj * HALF); const f32x4 o0 = r0[0] + acc[ai][bj][m][0] * alpha, o1 = r0[1] + acc[ai][bj][m][1] * alpha; p0[0] = o0; p0[1] = o1;
                    if (gnext) { sq += (o0[0] * o0[0] + o0[1] * o0[1]) + (o0[2] * o0[2] + o0[3] * o0[3]) + (o1[0] * o1[0] + o1[1] * o1[1]) + (o1[2] * o1[2] + o1[3] * o1[3]);
                        const f32x4 y0 = o0 * gv[bj][0], y1 = o1 * gv[bj][1];
                        u32x4 w; w.x = cvt_pk_bf16(y0[0], y0[1]); w.y = cvt_pk_bf16(y0[2], y0[3]); w.z = cvt_pk_bf16(y1[0], y1[1]); w.w = cvt_pk_bf16(y1[2], y1[3]);
                        *(u32x4*)(XNo + (size_t)row * DM + col0 + bj * HALF) = w; } }
                if (gnext) { sq += shfl_xor_l(sq, 16, lane); sq += shfl_xor_l(sq, 32, lane); if (fq == 0) part[wc * 256 + ai * HALF + wr * 64 + m * 16 + fr] = sq; }
                asm volatile("" ::: "memory"); }
        if (gnext) {
            asm volatile("s_waitcnt lgkmcnt(0)" ::: "memory"); __builtin_amdgcn_s_barrier(); asm volatile("" ::: "memory");
            const int t = (wr * 4 + wc) * 64 + lane;
            if (t < 256) ss[(size_t)u.pn * MT + u.pm * BM + t] = (part[t] + part[256 + t]) + (part[512 + t] + part[768 + t]);
        }
    }
};
template <int ACCUM> struct EpiGate {
    bf16_t* MG; const bf16_t* PB; const float* ss;
    __device__ __forceinline__ void operator()(const Acc& acc, const Unit& u, int wr, int wc, int fr, int fq) const {
        const int row0 = u.pm * BM + wr * 64 + fr, col0 = u.pn * BM + wc * 32 + 8 * fq;
#pragma unroll
        for (int ai = 0; ai < 2; ++ai)
#pragma unroll
            for (int m = 0; m < 4; ++m) { const int row = row0 + ai * HALF + m * 16; const size_t ro = (size_t)row * DM + col0; const float rs = 1.0f / sqrtf(((ss[row] + ss[MT + row]) + (ss[2 * MT + row] + ss[3 * MT + row])) * (1.f / DM) + EPS);
#pragma unroll
                for (int bj = 0; bj < 2; ++bj) { const u32x4 pb = *(const u32x4*)(PB + ro + bj * HALF); u32x4 old = {0u, 0u, 0u, 0u};
                    if (ACCUM) old = *(const u32x4*)(MG + ro + bj * HALF);
                    float r[8];
#pragma unroll
                    for (int e = 0; e < 8; ++e) { const float a = acc[ai][bj][m][e >> 2][e & 3] * rs; const unsigned pw = pb[e >> 1], ow = old[e >> 1];
                        const float pv = (e & 1) ? __uint_as_float(pw & 0xffff0000u) : __uint_as_float(pw << 16);
                        const float ov = (e & 1) ? __uint_as_float(ow & 0xffff0000u) : __uint_as_float(ow << 16);
                        r[e] = sigmoidf_(a) * pv + (ACCUM ? ov : 0.f); }
                    u32x4 w; w.x = cvt_pk_bf16(r[0], r[1]); w.y = cvt_pk_bf16(r[2], r[3]); w.z = cvt_pk_bf16(r[4], r[5]); w.w = cvt_pk_bf16(r[6], r[7]);
                    *(u32x4*)(MG + ro + bj * HALF) = w; } }
    }
};

__device__ __forceinline__ void glds16_s(const void* sbase, unsigned voff, unsigned lds_dst) {
    asm volatile("s_mov_b32 m0, %2\n\ts_nop 0\n\tglobal_load_lds_dwordx4 %0, %1" :: "v"(voff), "s"(sbase), "s"(lds_dst) : "memory", "m0"); }
template <class Epi>
__device__ __forceinline__ void gemm_phase(LAS unsigned char* lds, const Gemm g, const StaticOrder& S, const Epi& E, int wave) {
    const int tid = fresh_tid(wave), wid = wave, lane = tid & 63, wr = wid >> 2, wc = wid & 3, fr = lane & 15, fq = lane >> 4;
    const int K = g.K, nt = K / BK, lda = g.lda;
    unsigned voffA[2], voffB[2];
#pragma unroll
    for (int i = 0; i < 2; ++i) { int R, C; stage_rc(tid * 16 + i * 8192, R, C); const int Rb = (R & ~31) + perm32(R & 31);
        voffA[i] = (unsigned)(R * lda + C) * 2u; voffB[i] = (unsigned)(Rb * K + C) * 2u; }
    const size_t kstep = (size_t)(BK * 2);
    const size_t hstepA = (size_t)HALF * lda * 2, hstepB = (size_t)HALF * K * 2;
    const size_t tstepA = 2 * hstepA, tstepB = 2 * hstepB;
    const unsigned ldsw = (unsigned)wid * 1024u; const unsigned lds0 = (unsigned)(__UINTPTR_TYPE__)lds;
    const int aoff = lds_byte(wr * 64 + fr, fq * 8), boff = lds_byte(wc * 32 + fr, fq * 8);
#define PG8_SA(b, h) (((b) * 2 + (h)) * HTB)
#define PG8_SB(b, h) ((4 + (b) * 2 + (h)) * HTB)
#define PG8_STAGE(bufoff, gbase, voff) do { _Pragma("unroll") for (int _i = 0; _i < 2; ++_i) \
        glds16_s((const void*)(gbase), (voff)[_i], lds0 + (unsigned)((bufoff) + _i * 8192) + ldsw); } while (0)
#define PG8_LDA(dst, b, h) do { _Pragma("unroll") for (int m = 0; m < 4; ++m) _Pragma("unroll") for (int k = 0; k < 2; ++k) dst[m][k] = *(const LAS bf16x8*)(lds + PG8_SA(b, h) + aoff + m * 2048 + k * 1024); } while (0)
#define PG8_LDB(dst, b, h) do { _Pragma("unroll") for (int n = 0; n < 2; ++n) _Pragma("unroll") for (int k = 0; k < 2; ++k) dst[n][k] = *(const LAS bf16x8*)(lds + PG8_SB(b, h) + boff + n * 2048 + k * 1024); } while (0)
#define PG8_MMA(ai, bj, At, Bt) do { __builtin_amdgcn_s_setprio(1); _Pragma("unroll") for (int m = 0; m < 4; ++m) _Pragma("unroll") for (int n = 0; n < 2; ++n) _Pragma("unroll") for (int k = 0; k < 2; ++k) \
        acc[ai][bj][m][n] = __builtin_amdgcn_mfma_f32_16x16x32_bf16(Bt[n][k], At[m][k], acc[ai][bj][m][n], 0, 0, 0); __builtin_amdgcn_s_setprio(0); } while (0)
#define PG8_WAIT_V(n) asm volatile("s_waitcnt vmcnt(" #n ")" ::: "memory")
#define PG8_WAIT_L(n) asm volatile("s_waitcnt lgkmcnt(" #n ")" ::: "memory")
#define PG8_BAR __builtin_amdgcn_s_barrier()
#define PG8_SCHED __builtin_amdgcn_sched_barrier(0)
    Unit cur, nxt; int ui = 0;
    if (!S.next(0, cur)) return;
    float zf = 0.f; asm volatile("" : "+v"(zf));
    Acc acc;
#pragma unroll
    for (int a = 0; a < 2; ++a)
#pragma unroll
        for (int b = 0; b < 2; ++b)
#pragma unroll
            for (int m = 0; m < 4; ++m)
#pragma unroll
                for (int n = 0; n < 2; ++n) acc[a][b][m][n] = (f32x4){zf, zf, zf, zf};
    bf16x8 At[4][2], B0[2][2], B1[2][2];
    const char* cA = (const char*)g.A + (size_t)cur.pm * tstepA; const char* cB = (const char*)g.Bt + (size_t)cur.pn * tstepB;
    PG8_STAGE(PG8_SB(0, 0), cB, voffB); PG8_STAGE(PG8_SB(0, 1), cB + hstepB, voffB); PG8_STAGE(PG8_SA(0, 0), cA, voffA); PG8_STAGE(PG8_SA(0, 1), cA + hstepA, voffA);
    if (wr == 1) PG8_BAR;
    PG8_WAIT_V(2); PG8_BAR;
    PG8_STAGE(PG8_SB(1, 0), cB + kstep, voffB); PG8_STAGE(PG8_SA(1, 0), cA + kstep, voffA); PG8_STAGE(PG8_SB(1, 1), cB + hstepB + kstep, voffB);
    PG8_WAIT_V(6); PG8_BAR;
    for (;;) {
        const bool has_next = S.next(ui + 1, nxt);
        const char* nA = has_next ? (const char*)g.A + (size_t)nxt.pm * tstepA : cA; const char* nB = has_next ? (const char*)g.Bt + (size_t)nxt.pn * tstepB : cB;
        for (int t = 0; t < nt; t += 2) {
            const bool last = (t == nt - 2);
            const char* a1 = cA + (size_t)(t + 1) * kstep;
            const char* a2 = last ? nA : cA + (size_t)(t + 2) * kstep; const char* b2 = last ? nB : cB + (size_t)(t + 2) * kstep;
            const char* a3 = a2 + kstep; const char* b3 = b2 + kstep;
            PG8_LDB(B0, 0, 0); PG8_LDB(B1, 0, 1); PG8_SCHED; PG8_LDA(At, 0, 0); PG8_STAGE(PG8_SA(1, 1), a1 + hstepA, voffA);
            PG8_WAIT_V(8); PG8_WAIT_L(0); PG8_BAR; PG8_MMA(0, 0, At, B0); PG8_MMA(0, 1, At, B1); PG8_BAR; PG8_SCHED;
            PG8_LDA(At, 0, 1); PG8_STAGE(PG8_SB(0, 0), b2, voffB); PG8_STAGE(PG8_SB(0, 1), b2 + hstepB, voffB); PG8_STAGE(PG8_SA(0, 0), a2, voffA);
            PG8_WAIT_V(8); PG8_WAIT_L(0); PG8_BAR; PG8_MMA(1, 0, At, B0); PG8_MMA(1, 1, At, B1); PG8_BAR; PG8_SCHED;
            PG8_LDB(B0, 1, 0); PG8_LDB(B1, 1, 1); PG8_SCHED; PG8_LDA(At, 1, 0); PG8_STAGE(PG8_SA(0, 1), a2 + hstepA, voffA);
            PG8_WAIT_V(8); PG8_WAIT_L(0); PG8_BAR; PG8_MMA(0, 0, At, B0); PG8_MMA(0, 1, At, B1); PG8_BAR; PG8_SCHED;
            PG8_LDA(At, 1, 1); PG8_STAGE(PG8_SB(1, 0), b3, voffB); PG8_STAGE(PG8_SB(1, 1), b3 + hstepB, voffB); PG8_STAGE(PG8_SA(1, 0), a3, voffA);
            PG8_WAIT_V(8); PG8_WAIT_L(0); PG8_BAR; PG8_MMA(1, 0, At, B0); PG8_MMA(1, 1, At, B1); PG8_BAR; PG8_SCHED;
        }
        if (wr == 0) PG8_BAR;
        { const int l2 = fresh_lane(); E(acc, cur, wr, wc, l2 & 15, l2 >> 4); }
        if (!has_next) break;
#pragma unroll
        for (int a = 0; a < 2; ++a)
#pragma unroll
            for (int b = 0; b < 2; ++b)
#pragma unroll
                for (int m = 0; m < 4; ++m)
#pragma unroll
                    for (int n = 0; n < 2; ++n) acc[a][b][m][n] = (f32x4){zf, zf, zf, zf};
        cur = nxt; cA = nA; cB = nB; ++ui;
        if (wr == 1) PG8_BAR;
    }
    PG8_WAIT_V(0);
    PG8_BAR;
#undef PG8_SA
#undef PG8_SB
#undef PG8_STAGE
#undef PG8_LDA
#undef PG8_LDB
#undef PG8_MMA
#undef PG8_WAIT_V
#undef PG8_WAIT_L
#undef PG8_BAR
#undef PG8_SCHED
}
}

namespace att {
typedef __bf16 bf16x2_t __attribute__((ext_vector_type(2)));
__device__ __forceinline__ unsigned cvtpk_s(float lo, float hi) { f32x2 v = {lo, hi}; bf16x2_t b = __builtin_convertvector(v, bf16x2_t); return __builtin_bit_cast(unsigned, b); }
constexpr int NW = 8, QBLK = 32, KVBLK = 64;
constexpr float THR = 8.f;
constexpr int SHM_V = 16384, SHM_K = 16384;
#define KSWZ(row, colB) ((row) * 256 + ((colB) ^ (((row) & 7) << 4)))
#define SBAR() __builtin_amdgcn_sched_barrier(0)
__device__ __forceinline__ int crow(int r, int hi) { return (r & 3) + 8 * (r >> 2) + 4 * hi; }
template <int DKB> struct Sc { static constexpr float SCALE = DKB == 4 ? 0.125f : 0.10206207261596575f; };

constexpr float THR2 = 11.5f;
__device__ __forceinline__ float rowmax32(const f32x16& p0, const f32x16& p1) {
  float pmax = p0[0];
#pragma unroll
  for (int r = 1; r < 16; ++r) pmax = fmaxf(pmax, p0[r]);
#pragma unroll
  for (int r = 0; r < 16; ++r) pmax = fmaxf(pmax, p1[r]);
  auto rr = __builtin_amdgcn_permlane32_swap(__float_as_uint(pmax), __float_as_uint(pmax), false, false);
  return fmaxf(__uint_as_float(rr[0]), __uint_as_float(rr[1]));
}
template <bool FIRST> __device__ __forceinline__ void partialSM(f32x16& p0, f32x16& p1, float& m_reg, f32x16& negm, float& alpha) {
  const float pmax = rowmax32(p0, p1);
  alpha = 1.f;
  if (FIRST) { m_reg = pmax; p0 = p0 - pmax; p1 = p1 - pmax;
#pragma unroll
    for (int r = 0; r < 16; ++r) negm[r] = -m_reg; }
  else if (__builtin_expect(!__all(pmax <= THR2), 0)) { const float dl = fmaxf(pmax, 0.f); m_reg += dl; p0 = p0 - dl; p1 = p1 - dl; alpha = __builtin_amdgcn_exp2f(-dl);
#pragma unroll
    for (int r = 0; r < 16; ++r) negm[r] = -m_reg; }
#pragma unroll
  for (int r = 0; r < 16; ++r) p0[r] = __builtin_amdgcn_exp2f(p0[r]);
}
__device__ __forceinline__ void finishSM(f32x16& p0, f32x16& p1, bf16x8& pa0, bf16x8& pa1, bf16x8& pa2, bf16x8& pa3) {
#pragma unroll
  for (int r = 0; r < 16; ++r) p1[r] = __builtin_amdgcn_exp2f(p1[r]);
#define PK4(P, BASE, OUT) do { unsigned a0 = cvtpk_s(P[BASE + 0], P[BASE + 1]), a1 = cvtpk_s(P[BASE + 2], P[BASE + 3]);   \
    unsigned b0 = cvtpk_s(P[BASE + 4], P[BASE + 5]), b1 = cvtpk_s(P[BASE + 6], P[BASE + 7]);                              \
    auto r0 = __builtin_amdgcn_permlane32_swap(a0, b0, false, false); auto r1 = __builtin_amdgcn_permlane32_swap(a1, b1, false, false); \
    u32x4 w = {r0[0], r1[0], r0[1], r1[1]}; OUT = *reinterpret_cast<bf16x8*>(&w); } while (0)
  PK4(p0, 0, pa0); PK4(p0, 8, pa1); PK4(p1, 0, pa2); PK4(p1, 8, pa3);
#undef PK4
}
template <int DKB> __device__ __forceinline__ void qkt(f32x16& p0, f32x16& p1, const char* Ks, const bf16x8* qr, const f32x16& negm, int r32, int hi) {
#pragma unroll
  for (int d0 = 0; d0 < DKB; ++d0) { int cb = (d0 * 16 + hi * 8) * 2;
    bf16x8 b0 = *reinterpret_cast<const bf16x8*>(Ks + KSWZ(r32, cb));
    bf16x8 b1 = *reinterpret_cast<const bf16x8*>(Ks + KSWZ(32 + r32, cb));
    if (d0 == 0) { p0 = __builtin_amdgcn_mfma_f32_32x32x16_bf16(b0, qr[0], negm, 0, 0, 0); p1 = __builtin_amdgcn_mfma_f32_32x32x16_bf16(b1, qr[0], negm, 0, 0, 0); }
    else { p0 = __builtin_amdgcn_mfma_f32_32x32x16_bf16(b0, qr[d0], p0, 0, 0, 0); p1 = __builtin_amdgcn_mfma_f32_32x32x16_bf16(b1, qr[d0], p1, 0, 0, 0); } }
}
__device__ __forceinline__ int v_st(int k, int c) { const int kk = (k & ~0xC) | ((k & 4) << 1) | ((k & 8) >> 1); return ((kk >> 3) * 4 + (c >> 5)) * 512 + ((kk & 7) * 32 + (c & 31)) * 2; }
__device__ __forceinline__ int v_rd_base(int lane) { return ((lane & 3) << 3) | (((lane >> 2) & 3) << 6) | (((lane >> 4) & 1) << 5) | (((lane >> 5) & 1) << 8); }
constexpr int v_rd_off(int d0, int ks, int half) { return d0 * 512 + ks * 4096 + half * 2048; }
template <int OFF> __device__ __forceinline__ s16x4 tr_read(int vb) {
  s16x4 r; asm volatile("ds_read_b64_tr_b16 %0, %1 offset:%2" : "=&v"(r) : "v"(vb), "i"(OFF) : "memory"); return r;
}
template <int D0> __device__ __forceinline__ void pv_one(f32x16& od, int vb, bf16x8 pa0, bf16x8 pa1, bf16x8 pa2, bf16x8 pa3) {
  const s16x4 l0 = tr_read<v_rd_off(D0, 0, 0)>(vb), h0 = tr_read<v_rd_off(D0, 0, 1)>(vb), l1 = tr_read<v_rd_off(D0, 1, 0)>(vb), h1 = tr_read<v_rd_off(D0, 1, 1)>(vb);
  const s16x4 l2 = tr_read<v_rd_off(D0, 2, 0)>(vb), h2 = tr_read<v_rd_off(D0, 2, 1)>(vb), l3 = tr_read<v_rd_off(D0, 3, 0)>(vb), h3 = tr_read<v_rd_off(D0, 3, 1)>(vb);
  asm volatile("s_waitcnt lgkmcnt(0)" ::: "memory"); SBAR();
#define PK(L, H) (bf16x8){L[0], L[1], L[2], L[3], H[0], H[1], H[2], H[3]}
  od = __builtin_amdgcn_mfma_f32_32x32x16_bf16(pa0, PK(l0, h0), od, 0, 0, 0);
  od = __builtin_amdgcn_mfma_f32_32x32x16_bf16(pa1, PK(l1, h1), od, 0, 0, 0);
  od = __builtin_amdgcn_mfma_f32_32x32x16_bf16(pa2, PK(l2, h2), od, 0, 0, 0);
  od = __builtin_amdgcn_mfma_f32_32x32x16_bf16(pa3, PK(l3, h3), od, 0, 0, 0);
#undef PK
}
__device__ __forceinline__ void pv_d0(f32x16* o, int vb, bf16x8 pa0, bf16x8 pa1, bf16x8 pa2, bf16x8 pa3) {
  const bf16x8 ones = {16256, 16256, 16256, 16256, 16256, 16256, 16256, 16256};
  pv_one<0>(o[0], vb, pa0, pa1, pa2, pa3);
  o[2] = __builtin_amdgcn_mfma_f32_32x32x16_bf16(pa0, ones, o[2], 0, 0, 0); o[2] = __builtin_amdgcn_mfma_f32_32x32x16_bf16(pa1, ones, o[2], 0, 0, 0);
  pv_one<1>(o[1], vb, pa0, pa1, pa2, pa3);
  o[2] = __builtin_amdgcn_mfma_f32_32x32x16_bf16(pa2, ones, o[2], 0, 0, 0); o[2] = __builtin_amdgcn_mfma_f32_32x32x16_bf16(pa3, ones, o[2], 0, 0, 0);
}
template <int DKB>
__device__ __forceinline__ void attn_unit(const bf16_t* Qb, int ldq, const bf16_t* K1, int ldk1, const bf16_t* K2, int ldk2, const bf16_t* Vh, int ldv, bf16_t* Ob, int ldo, int seq, char* lds, int tq0, const f32x2* tab, int wave) {
  const int tid = fresh_tid(wave), wid = wave, lane = tid & 63, r32 = lane & 31, hi = lane >> 5;
  char* V_lds = lds; char* K_lds = lds + 3 * SHM_V;
  float* ws = (float*)(lds + 3 * SHM_V + 3 * SHM_K) + wid * 64; float* al_l = ws + 32;
  float m_reg = 0.f; f32x16 o[3] = {}; bf16x8 qr[DKB]; f32x16 negm = {};
  constexpr float QC = Sc<DKB>::SCALE * 1.4426950408889634f;
  const bf16_t* Qw = Qb + (long)(wid * QBLK + r32) * ldq + hi * 8;
#pragma unroll
  for (int d0 = 0; d0 < DKB; ++d0) { u32x4 w = *reinterpret_cast<const u32x4*>(Qw + d0 * 16);
    if (DKB == 6 && d0 >= 4) {
      const int tq = tq0 + wid * QBLK + r32; const f32x2* tb = tab + (d0 == 4 ? (tq >> 6) : (tq & 63)) * 8 + hi * 4;
#pragma unroll
      for (int e = 0; e < 4; ++e) { const f32x2 cs = tb[e]; const float x0 = __uint_as_float(w[e] << 16), x1 = __uint_as_float(w[e] & 0xffff0000u);
        w[e] = cvt_pk_bf16((x0 * cs.x - x1 * cs.y) * QC, (x0 * cs.y + x1 * cs.x) * QC); }
    } else {
#pragma unroll
      for (int e = 0; e < 4; ++e) w[e] = cvt_pk_bf16(__uint_as_float(w[e] << 16) * QC, __uint_as_float(w[e] & 0xffff0000u) * QC); }
    qr[d0] = *reinterpret_cast<bf16x8*>(&w); }
  const int sr = tid >> 3, sc = (tid & 7) * 8, vst0 = v_st(sr, sc), kst0 = KSWZ(sr, sc * 2);
  const int sr2 = (tid & 255) >> 2, sc2 = (tid & 3) * 8, kst2 = KSWZ(sr2, (64 + sc2) * 2);
  const int vb0 = (int)(uintptr_t)V_lds + v_rd_base(lane);
  struct { bf16x8 vs, ks, k2; } sr_[2];
#define SLOAD(i, k0) do { sr_[i].vs = *reinterpret_cast<const bf16x8*>(&Vh[(long)((k0) + sr) * ldv + sc]); sr_[i].ks = *reinterpret_cast<const bf16x8*>(&K1[(long)((k0) + sr) * ldk1 + sc]); \
    if (DKB == 6) sr_[i].k2 = *reinterpret_cast<const bf16x8*>(&K2[(long)((k0) + sr2) * ldk2 + sc2]); } while (0)
#define SWRITE(off, i) do { *(bf16x8*)(V_lds + (off) + vst0) = sr_[i].vs; *(bf16x8*)(K_lds + (off) + kst0) = sr_[i].ks; \
    if (DKB == 6) *(bf16x8*)(K_lds + (off) + kst2) = sr_[i].k2; } while (0)
#define SWAIT() do { if (DKB == 6) asm volatile("s_waitcnt vmcnt(3)" ::: "memory"); else asm volatile("s_waitcnt vmcnt(2)" ::: "memory"); } while (0)
#define RESC(a) do { if (__any((a) < 1.f)) { if (hi == 0) al_l[r32] = (a); asm volatile("s_waitcnt lgkmcnt(0)" ::: "memory"); \
    _Pragma("unroll") for (int d = 0; d < 3; ++d) _Pragma("unroll") for (int r = 0; r < 16; ++r) o[d][r] *= al_l[crow(r, hi)]; } } while (0)
#define ROT() do { o_prev = o_cur; o_cur = o_next; o_next = (o_next == 2 * SLOT) ? 0 : o_next + SLOT; } while (0)
  constexpr int SLOT = 16384;
  f32x16 pA0, pA1, pB0, pB1; float alA, alB; bf16x8 pa0, pa1, pa2, pa3; const int NT = seq / KVBLK;
  constexpr int SE = 0, SO = 1;
  int o_prev = 0, o_cur = 0, o_next = SLOT;
  SLOAD(SE, 0); asm volatile("s_waitcnt vmcnt(0)" ::: "memory"); SWRITE(0, SE); __syncthreads();
  qkt<DKB>(pA0, pA1, K_lds, qr, negm, r32, hi); partialSM<true>(pA0, pA1, m_reg, negm, alA);
  SLOAD(SO, KVBLK); if (2 < NT) SLOAD(SE, 2 * KVBLK);
  SWAIT(); SWRITE(SLOT, SO); __syncthreads();
  ROT();
  for (int j = 1; j + 1 < NT; j += 2) {
    SBAR(); qkt<DKB>(pB0, pB1, K_lds + o_cur, qr, negm, r32, hi);
    finishSM(pA0, pA1, pa0, pa1, pa2, pa3); SBAR();
    SLOAD(SO, (j + 2) * KVBLK); SBAR();
    pv_d0(o, vb0 + o_prev, pa0, pa1, pa2, pa3); partialSM<false>(pB0, pB1, m_reg, negm, alB);
    SWAIT(); SWRITE(o_next, SE);
    RESC(alB); __syncthreads(); ROT();
    SBAR(); qkt<DKB>(pA0, pA1, K_lds + o_cur, qr, negm, r32, hi);
    finishSM(pB0, pB1, pa0, pa1, pa2, pa3); SBAR();
    if (j + 3 < NT) SLOAD(SE, (j + 3) * KVBLK); SBAR();
    pv_d0(o, vb0 + o_prev, pa0, pa1, pa2, pa3); partialSM<false>(pA0, pA1, m_reg, negm, alA);
    SWAIT(); SWRITE(o_next, SO);
    RESC(alA); __syncthreads(); ROT();
  }
  SBAR(); qkt<DKB>(pB0, pB1, K_lds + o_cur, qr, negm, r32, hi);
  finishSM(pA0, pA1, pa0, pa1, pa2, pa3); SBAR();
  pv_d0(o, vb0 + o_prev, pa0, pa1, pa2, pa3); partialSM<false>(pB0, pB1, m_reg, negm, alB);
  RESC(alB);
  finishSM(pB0, pB1, pa0, pa1, pa2, pa3); SBAR();
  pv_d0(o, vb0 + o_cur, pa0, pa1, pa2, pa3);
  float rli[16];
#pragma unroll
  for (int r = 0; r < 16; ++r) rli[r] = __builtin_amdgcn_rcpf(o[2][r]);
  bf16_t* Ow = Ob + (long)(wid * QBLK) * ldo;
#pragma unroll
  for (int r = 0; r < 16; ++r) { int orow = crow(r, hi);
#pragma unroll
    for (int d0 = 0; d0 < 2; ++d0) Ow[(long)orow * ldo + d0 * 32 + r32] = (bf16_t)f2bf(o[d0][r] * rli[r]); }
  __syncthreads();
#undef SLOAD
#undef SWRITE
#undef SWAIT
#undef RESC
#undef ROT
}
#undef SBAR
}

struct Ctx { int wave, G, bid; };
#define CTX_GW(c) ((c).bid * 8 + (c).wave)
#define CTX_NGW(c) ((c).G * 8)
#define CTX_VCU(c) (((c).G % 8 == 0) ? ((c).bid % 8) * ((c).G / 8) + (c).bid / 8 : (c).bid)
#define LOCAL_TID const int tid = c.wave * 64 + fresh_lane(); const int lane = tid & 63; (void)lane;

__device__ __forceinline__ void tr_item(const float* W, int ldw, int Kd, int k0, int n0, bf16_t* WT, int drow0, LAS float* scr, int lane) {
#pragma unroll 8
    for (int i = 0; i < 32; ++i) { const int kk = 2 * i + (lane >> 5); scr[kk * 33 + (lane & 31)] = W[(size_t)(k0 + kk) * ldw + n0 + (lane & 31)]; }
    asm volatile("s_waitcnt lgkmcnt(0)" ::: "memory");
    const int c = lane & 7;
#pragma unroll
    for (int j = 0; j < 4; ++j) { const int n = (lane >> 3) + 8 * j; const LAS float* s = scr + (8 * c) * 33 + n;
        u32x4 o; o.x = pk2(s[0 * 33], s[1 * 33]); o.y = pk2(s[2 * 33], s[3 * 33]); o.z = pk2(s[4 * 33], s[5 * 33]); o.w = pk2(s[6 * 33], s[7 * 33]);
        *(u32x4*)(WT + (size_t)(drow0 + n) * Kd + k0 + 8 * c) = o; }
    asm volatile("s_waitcnt lgkmcnt(0)" ::: "memory");
}
struct LayerW { const float *gate1, *up1, *dn1, *win, *uq, *ukv, *br, *wout, *gate2, *up2, *dn2; };
__device__ __forceinline__ void convert_weights(const Ctx& c, const LayerW& w, bf16_t* WB, LAS unsigned char* lds) {
    LOCAL_TID
    LAS float* scr = (LAS float*)(lds + c.wave * 16384);
    constexpr int I_G = 16 * 88, I_D = 44 * 32, I_IN = 16 * 85, I_GT = 16 * 96, I_UQ = 4 * 24, I_UKV = 2 * 32, I_BR = 8 * 32, I_OUT = 16 * 32;
    constexpr int NITEMS = 4 * I_G + 2 * I_D + I_IN + I_GT + I_UQ + I_UKV + 3 * I_BR + I_OUT;
    for (int it = CTX_GW(c); it < NITEMS; it += CTX_NGW(c)) {
        int r = it;
#define FFN_GU(src, dst, upofs) { const int kb = r / 88, nb = r % 88, n0 = nb * 32; tr_item(src, DFF, DM, kb * 64, n0, dst, (n0 >> 7) * 256 + (upofs) + (n0 & 127), scr, lane); }
        if (r < I_G) { FFN_GU(w.gate1, WB + WO_GU1, 0); continue; } r -= I_G;
        if (r < I_G) { FFN_GU(w.up1, WB + WO_GU1, 128); continue; } r -= I_G;
        if (r < I_G) { FFN_GU(w.gate2, WB + WO_GU2, 0); continue; } r -= I_G;
        if (r < I_G) { FFN_GU(w.up2, WB + WO_GU2, 128); continue; } r -= I_G;
#undef FFN_GU
        if (r < I_D) { const int kb = r / 32, nb = r % 32; tr_item(w.dn1, DM, DFF, kb * 64, nb * 32, WB + WO_DN1, nb * 32, scr, lane); continue; } r -= I_D;
        if (r < I_D) { const int kb = r / 32, nb = r % 32; tr_item(w.dn2, DM, DFF, kb * 64, nb * 32, WB + WO_DN2, nb * 32, scr, lane); continue; } r -= I_D;
        if (r < I_IN) { const int kb = r / 85, nb = r % 85; tr_item(w.win, 5792, DM, kb * 64, nb * 32, WB + WO_IN, nb * 32, scr, lane); continue; } r -= I_IN;
        if (r < I_GT) { const int kb = r / 96, nb = r % 96; tr_item(w.win, 5792, DM, kb * 64, 2720 + nb * 32, WB + WO_GATE, nb * 32, scr, lane); continue; } r -= I_GT;
        if (r < I_UQ) { const int kb = r / 24, nb = r % 24; tr_item(w.uq, 768, 256, kb * 64, nb * 32, WB + WO_UQ, nb * 32, scr, lane); continue; } r -= I_UQ;
        if (r < I_UKV) { const int kb = r / 32, nb = r % 32; tr_item(w.ukv, 1024, 128, kb * 64, nb * 32, WB + WO_UKV, nb * 32, scr, lane); continue; } r -= I_UKV;
        if (r < 3 * I_BR) { const int bi = r / I_BR, q = r % I_BR, kb = q / 32, nb = q % 32; tr_item(w.br + (size_t)bi * 512 * 1024, DM, 512, kb * 64, nb * 32, WB + WO_BR + (size_t)bi * 1024 * 512, nb * 32, scr, lane); continue; } r -= 3 * I_BR;
        { const int kb = r / 32, nb = r % 32; tr_item(w.wout, DM, DM, kb * 64, nb * 32, WB + WO_OUT, nb * 32, scr, lane); }
    }
    { unsigned zz = 0u; asm volatile("" : "+v"(zz));
      for (int i = c.bid * 512 + tid; i < 96 * 1024 / 8; i += c.G * 512) ((u32x4*)(WB + WO_IN + (size_t)2720 * 1024))[i] = (u32x4){zz, zz, zz, zz}; }
}

template <int MODE>
__device__ __forceinline__ void norm_rows(const Ctx& c, const float* xp, const float* xs, float* xbuf, const float* g, bf16_t* XN) {
    LOCAL_TID
    const f32x4* g4 = (const f32x4*)g + lane;
    f32x4 gv[4];
#pragma unroll
    for (int j = 0; j < 4; ++j) gv[j] = g4[64 * j];
    constexpr int RB = 4;
    for (int m0 = CTX_GW(c); m0 < MT; m0 += RB * CTX_NGW(c)) {
        f32x4 v[RB][4];
#pragma unroll
        for (int q = 0; q < RB; ++q) { const int m = m0 + q * CTX_NGW(c); if (m < MT) {
            const float* src = (MODE == 1) ? (m < MP ? xp + (size_t)m * DM : xs + (size_t)(m - MP) * DM) : xbuf + (size_t)m * DM;
            const f32x4* xr = (const f32x4*)src + lane;
#pragma unroll
            for (int j = 0; j < 4; ++j) v[q][j] = xr[64 * j]; } }
#pragma unroll
        for (int q = 0; q < RB; ++q) { const int m = m0 + q * CTX_NGW(c); if (m < MT) {
            float s = 0.f;
#pragma unroll
            for (int j = 0; j < 4; ++j) s += (v[q][j].x * v[q][j].x + v[q][j].y * v[q][j].y) + (v[q][j].z * v[q][j].z + v[q][j].w * v[q][j].w);
            const float rstd = 1.0f / sqrtf(wave_sum(s, lane) * (1.f / DM) + EPS);
            if (MODE == 2) { f32x4* xo = (f32x4*)(xbuf + (size_t)m * DM) + lane;
#pragma unroll
                for (int j = 0; j < 4; ++j) xo[64 * j] = v[q][j] * rstd * gv[j]; }
            else { u32x2* o8 = (u32x2*)(XN + (size_t)m * DM) + lane;
#pragma unroll
                for (int j = 0; j < 4; ++j) { const f32x4 y = v[q][j] * rstd * gv[j]; u32x2 w; w.x = pk2(y.x, y.y); w.y = pk2(y.z, y.w); o8[64 * j] = w; } } } }
    }
}

__device__ __forceinline__ void misc_tables(const Ctx& c, unsigned char* ws, const float* w1, const float* b1, const float* w2, const float* b2, const float* freq) {
    LOCAL_TID
    f32x2* T2 = (f32x2*)(ws + WS_T2); f32x2* tabA = (f32x2*)(ws + WS_TABA); f32x2* tabM = (f32x2*)(ws + WS_TABM);
    const int gt = c.bid * 512 + tid, NT = c.G * 512;
    for (int j = gt; j < 8192; j += NT) { const float a = (float)j * (1.0f / 8192.0f); T2[j] = (f32x2){cospif(a), -sinpif(a)}; }
    for (int i = gt; i < 128 * 16; i += NT) { const int pos = i >> 4, f = i & 15; const float inv = powf(10000.0f, -(float)f / 16.0f); const float a = (float)pos * inv; tabA[i] = (f32x2){cosf(a), sinf(a)}; }
    for (int i = gt; i < 128 * 8; i += NT) { const int pos = i >> 3, f = i & 7; const float inv = powf(10000.0f, -(float)f / 8.0f); const float a = (float)pos * inv; tabM[i] = (f32x2){cosf(a), sinf(a)}; }
    for (int r = CTX_GW(c); r < 2 * 12288; r += CTX_NGW(c)) {
        const int l = r / 12288, q = r % 12288; const int L = q < 8192 ? 8192 : 4096; const int t = q < 8192 ? q : q - 8192;
        float* H2 = (float*)(ws + WS_H2 + (size_t)l * 3 * MiB) + (q < 8192 ? 0 : 8192 * 64) + (size_t)t * 64;
        const float tl = (float)t / (float)(L - 1); const float wv = 6.283185307179586f * (float)t / (float)L;
        float z = 0.f;
        if (lane == 0) z = tl;
        else if (lane < 33) { const int k = (lane - 1) & 15; const float f = 1e-4f + (float)k * ((15.0f - 1e-4f) / 15.0f); z = lane < 17 ? cosf(f * wv) : -sinf(f * wv); }
        const float* W1 = w1 + l * 33 * 64; const float* W2 = w2 + l * 64 * 64; const float fr = freq[l * 64 + lane];
        float a = b1[l * 64 + lane];
#pragma unroll
        for (int i = 0; i < 33; ++i) a += bcast_l(z, i) * W1[i * 64 + lane];
        const float h1 = sinf(fr * a);
        float a2 = b2[l * 64 + lane];
#pragma unroll 8
        for (int k = 0; k < 64; ++k) a2 += bcast_l(h1, k) * W2[k * 64 + lane];
        H2[lane] = sinf(fr * a2);
    }
}

__device__ __forceinline__ void tok_local(const Ctx& c, bf16_t* ZC, const float* gq, const float* gk, const float* gmq, const float* gmkv, const f32x2* tabA, const f32x2* tabM) {
    LOCAL_TID
    constexpr int RB = 4;
    for (int m0 = CTX_GW(c); m0 < MT; m0 += RB * CTX_NGW(c)) {
        unsigned raw[RB][9];
#pragma unroll
        for (int q = 0; q < RB; ++q) { const int m = m0 + q * CTX_NGW(c); if (m < MT) { const unsigned* zr = (const unsigned*)(ZC + (size_t)m * ZCW);
#pragma unroll
            for (int it = 0; it < 5; ++it) raw[q][it] = zr[it * 64 + lane];
            raw[q][5] = zr[C_CQ / 2 + lane]; raw[q][6] = zr[C_CQ / 2 + 64 + lane]; raw[q][7] = zr[C_CKV / 2 + lane]; raw[q][8] = zr[C_KR / 2 + (lane & 15)]; } }
#pragma unroll
        for (int q = 0; q < RB; ++q) { const int m = m0 + q * CTX_NGW(c); if (m < MT) {
        unsigned* zr = (unsigned*)(ZC + (size_t)m * ZCW); const int t = m < MP ? (m & (LP - 1)) : (m & (LS - 1));
#pragma unroll
        for (int it = 0; it < 5; ++it) { const int pidx = it * 64 + lane, head = pidx >> 5, pi = pidx & 31;
            const unsigned rw = raw[q][it]; const float x0 = bf2f(rw & 0xffffu), x1 = bf2f(rw >> 16);
            float ss = x0 * x0 + x1 * x1;
#pragma unroll
            for (int o = 1; o < 32; o <<= 1) ss += shfl_xor_l(ss, o, lane);
            const float r = 1.0f / sqrtf(ss * (1.f / 64.f) + EPS); const float* g = head < 8 ? gq : gk;
            const float n0 = x0 * r * g[2 * pi], n1 = x1 * r * g[2 * pi + 1];
            const int pos = pi < 16 ? (t >> 6) : (t & 63); const f32x2 cs = tabA[pos * 16 + (pi & 15)];
            zr[pidx] = pk2(n0 * cs.x - n1 * cs.y, n0 * cs.y + n1 * cs.x); }
        { const unsigned r0 = raw[q][5], r1 = raw[q][6];
          const float a0 = bf2f(r0 & 0xffffu), a1 = bf2f(r0 >> 16), b0 = bf2f(r1 & 0xffffu), b1 = bf2f(r1 >> 16);
          const float r = 1.0f / sqrtf(wave_sum(a0 * a0 + a1 * a1 + b0 * b0 + b1 * b1, lane) * (1.f / 256.f) + EPS);
          zr[C_CQ / 2 + lane] = pk2(a0 * r * gmq[2 * lane], a1 * r * gmq[2 * lane + 1]); zr[C_CQ / 2 + 64 + lane] = pk2(b0 * r * gmq[128 + 2 * lane], b1 * r * gmq[128 + 2 * lane + 1]); }
        { const unsigned r0 = raw[q][7]; const float a0 = bf2f(r0 & 0xffffu), a1 = bf2f(r0 >> 16);
          const float r = 1.0f / sqrtf(wave_sum(a0 * a0 + a1 * a1, lane) * (1.f / 128.f) + EPS);
          zr[C_CKV / 2 + lane] = pk2(a0 * r * gmkv[2 * lane], a1 * r * gmkv[2 * lane + 1]); }
        if (lane < 16) { const unsigned r0 = raw[q][8]; const float x0 = bf2f(r0 & 0xffffu), x1 = bf2f(r0 >> 16);
          const int pos = lane < 8 ? (t >> 6) : (t & 63); const f32x2 cs = tabM[pos * 8 + (lane & 7)];
          zr[C_KR / 2 + lane] = pk2(x0 * cs.x - x1 * cs.y, x0 * cs.y + x1 * cs.x); }
        } }
    }
}

__device__ __forceinline__ void short_conv8(const bf16_t* ZC, int m, int t, int L, int col, const float* wsh, const float* bsh, int hc, float* out) {
    const u32x4 zc = *(const u32x4*)(ZC + (size_t)m * ZCW + col);
    u32x4 zm = {0u, 0u, 0u, 0u}, zp = {0u, 0u, 0u, 0u};
    if (t > 0) zm = *(const u32x4*)(ZC + (size_t)(m - 1) * ZCW + col);
    if (t < L - 1) zp = *(const u32x4*)(ZC + (size_t)(m + 1) * ZCW + col);
#pragma unroll
    for (int e = 0; e < 8; ++e) { const unsigned a = zm[e >> 1], b = zc[e >> 1], d = zp[e >> 1];
        const float xm = (e & 1) ? __uint_as_float(a & 0xffff0000u) : __uint_as_float(a << 16);
        const float xc = (e & 1) ? __uint_as_float(b & 0xffff0000u) : __uint_as_float(b << 16);
        const float xp = (e & 1) ? __uint_as_float(d & 0xffff0000u) : __uint_as_float(d << 16);
        out[e] = xm * wsh[hc + e] + xc * wsh[1536 + hc + e] + xp * wsh[3072 + hc + e] + bsh[hc + e]; }
}
__device__ __forceinline__ void hy_fwd_tiles(const Ctx& c, const bf16_t* ZC, bf16_t* ST, const float* wsh, const float* bsh, LAS unsigned char* lds) {
    LOCAL_TID
    LAS bf16_t* T = (LAS bf16_t*)lds;
    const int tt = tid >> 3, cgp = tid & 7;
    for (int tile = c.bid; tile < (MT / 256) * 8; tile += c.G) {
        const int c0 = (tile & 7) * 64, mb = (tile >> 3) * 256; const int L = mb < MP ? LP : LS; const int ch = c0 + cgp * 8;
#pragma unroll
        for (int q = 0; q < 4; ++q) { const int m0 = mb + q * 64, t0 = m0 & (L - 1); const int m = m0 + tt, t = t0 + tt;
            float a[8], b[8];
            short_conv8(ZC, m, t, L, C_HY + 512 + ch, wsh, bsh, 512 + ch, a);
            short_conv8(ZC, m, t, L, C_HY + 1024 + ch, wsh, bsh, 1024 + ch, b);
#pragma unroll
            for (int e = 0; e < 8; ++e) T[q * 4608 + (cgp * 8 + e) * 72 + tt] = (bf16_t)f2bf(a[e] * b[e]); }
        __syncthreads();
#pragma unroll
        for (int q = 0; q < 4; ++q) { const int m0 = mb + q * 64, t0 = m0 & (L - 1), rb = m0 - t0; const int cl = tid >> 3, tch = tid & 7;
            const u32x4 v = *(const LAS u32x4*)(T + q * 4608 + cl * 72 + tch * 8);
            *(u32x4*)(ST + (size_t)rb * 512 + (size_t)(c0 + cl) * L + t0 + tch * 8) = v; }
        __syncthreads();
    }
}
__device__ __forceinline__ void hy_bwd_tiles(const Ctx& c, bf16_t* ZC, const bf16_t* ST, const float* wsh, const float* bsh, LAS unsigned char* lds) {
    LOCAL_TID
    LAS bf16_t* T = (LAS bf16_t*)lds;
    const int tt = tid >> 3, cgp = tid & 7;
    for (int tile = c.bid; tile < (MT / 256) * 8; tile += c.G) {
        const int c0 = (tile & 7) * 64, mb = (tile >> 3) * 256; const int L = mb < MP ? LP : LS; const int ch = c0 + cgp * 8;
#pragma unroll
        for (int q = 0; q < 4; ++q) { const int m0 = mb + q * 64, t0 = m0 & (L - 1), rb = m0 - t0; const int cl = tid >> 3, tch = tid & 7;
            const u32x4 v = *(const u32x4*)(ST + (size_t)rb * 512 + (size_t)(c0 + cl) * L + t0 + tch * 8);
            *(LAS u32x4*)(T + q * 4608 + cl * 72 + tch * 8) = v; }
        __syncthreads();
#pragma unroll
        for (int q = 0; q < 4; ++q) { const int m0 = mb + q * 64, t0 = m0 & (L - 1); const int m = m0 + tt, t = t0 + tt;
            float a[8];
            short_conv8(ZC, m, t, L, C_HY + ch, wsh, bsh, ch, a);
            float r[8];
#pragma unroll
            for (int e = 0; e < 8; ++e) r[e] = a[e] * bf2f(T[q * 4608 + (cgp * 8 + e) * 72 + tt]);
            u32x4 w; w.x = pk2(r[0], r[1]); w.y = pk2(r[2], r[3]); w.z = pk2(r[4], r[5]); w.w = pk2(r[6], r[7]);
            *(u32x4*)(ZC + (size_t)m * ZCW + C_YB + ch) = w; }
        __syncthreads();
    }
}

__device__ __forceinline__ float fadd_(float a, float b) { float r; asm("v_add_f32_e32 %0, %1, %2" : "=v"(r) : "v"(a), "v"(b)); return r; }
__device__ __forceinline__ float fsub_(float a, float b) { float r; asm("v_sub_f32_e32 %0, %1, %2" : "=v"(r) : "v"(a), "v"(b)); return r; }
__device__ __forceinline__ float fmul_(float a, float b) { float r; asm("v_mul_f32_e32 %0, %1, %2" : "=v"(r) : "v"(a), "v"(b)); return r; }
__device__ __forceinline__ float ffma_(float a, float b, float c) { float r; asm("v_fma_f32 %0, %1, %2, %3" : "=v"(r) : "v"(a), "v"(b), "v"(c)); return r; }
__device__ __forceinline__ float fnma_(float a, float b, float c) { float r; asm("v_fma_f32 %0, -%1, %2, %3" : "=v"(r) : "v"(a), "v"(b), "v"(c)); return r; }
__device__ __forceinline__ f32x2 cadd(f32x2 a, f32x2 b) { return (f32x2){fadd_(a.x, b.x), fadd_(a.y, b.y)}; }
__device__ __forceinline__ f32x2 csub(f32x2 a, f32x2 b) { return (f32x2){fsub_(a.x, b.x), fsub_(a.y, b.y)}; }
__device__ __forceinline__ f32x2 cscale(f32x2 a, float s) { return (f32x2){fmul_(a.x, s), fmul_(a.y, s)}; }
__device__ __forceinline__ f32x2 cmul(f32x2 a, f32x2 b) { return (f32x2){fnma_(a.y, b.y, fmul_(a.x, b.x)), ffma_(a.y, b.x, fmul_(a.x, b.y))}; }
__device__ __forceinline__ f32x2 cmulc(f32x2 a, f32x2 b) { return (f32x2){ffma_(a.y, b.y, fmul_(a.x, b.x)), fnma_(a.x, b.y, fmul_(a.y, b.x))}; }
__device__ __forceinline__ int PADI(int i) { return i + (i >> 4); }
__device__ __forceinline__ constexpr float c16f(int m) { return m == 0 ? 1.f : m == 1 ? 0.92387953251128674f : m == 2 ? 0.70710678118654752f : m == 3 ? 0.38268343236508977f : m == 4 ? 0.f : m == 5 ? -0.38268343236508977f : m == 6 ? -0.70710678118654752f : -0.92387953251128674f; }
__device__ __forceinline__ constexpr float s16f(int m) { return m == 0 ? 0.f : m == 1 ? 0.38268343236508977f : m == 2 ? 0.70710678118654752f : m == 3 ? 0.92387953251128674f : m == 4 ? 1.f : m == 5 ? 0.92387953251128674f : m == 6 ? 0.70710678118654752f : 0.38268343236508977f; }
#define CW16(m) ((f32x2){(m) == 0 ? 1.f : (m) == 1 ? k1 : (m) == 2 ? k2 : (m) == 3 ? k3 : (m) == 4 ? 0.f : (m) == 5 ? -k3 : (m) == 6 ? -k2 : -k1, (m) == 0 ? 0.f : (m) == 1 ? -k3 : (m) == 2 ? -k2 : (m) == 3 ? -k1 : (m) == 4 ? -1.f : (m) == 5 ? -k1 : (m) == 6 ? -k2 : -k3})
template <int R, bool UNIT> __device__ __forceinline__ void dif_regs(f32x2* v, f32x2 wb) {
    float k1 = 0.92387953251128674f, k2 = 0.70710678118654752f, k3 = 0.38268343236508977f; asm volatile("" : "+v"(k1), "+v"(k2), "+v"(k3));
#pragma unroll
    for (int t = 0; t < R; ++t) { constexpr int dummy = 0; (void)dummy; const int half = 1 << (R - 1 - t);
#pragma unroll
        for (int k = 0; k < (1 << R); ++k) if (!(k & half)) { const int kk = k & (half - 1), m = kk * (8 / half);
            const f32x2 a = v[k], b = v[k + half]; v[k] = cadd(a, b); const f32x2 d = csub(a, b);
            if (UNIT) { v[k + half] = (m == 0) ? d : (m == 4) ? (f32x2){d.y, -d.x} : cmul(d, CW16(m)); }
            else { const f32x2 tw = (m == 0) ? wb : cmul(wb, CW16(m)); v[k + half] = cmul(d, tw); } }
        if (!UNIT) wb = cmul(wb, wb); }
}
template <int R, bool UNIT> __device__ __forceinline__ void dit_regs(f32x2* v, f32x2 wbig) {
    float k1 = 0.92387953251128674f, k2 = 0.70710678118654752f, k3 = 0.38268343236508977f; asm volatile("" : "+v"(k1), "+v"(k2), "+v"(k3));
    f32x2 wbs[R]; wbs[R - 1] = wbig;
#pragma unroll
    for (int t = R - 2; t >= 0; --t) wbs[t] = cmul(wbs[t + 1], wbs[t + 1]);
#pragma unroll
    for (int t = 0; t < R; ++t) { const int half = 1 << t;
#pragma unroll
        for (int k = 0; k < (1 << R); ++k) if (!(k & half)) { const int kk = k & (half - 1), m = kk * (8 / half);
            const f32x2 a = v[k]; f32x2 b = v[k + half];
            if (UNIT) { if (m == 4) b = (f32x2){-b.y, b.x}; else if (m != 0) b = cmulc(b, CW16(m)); }
            else { const f32x2 tw = (m == 0) ? wbs[t] : cmul(wbs[t], CW16(m)); b = cmulc(b, tw); }
            v[k] = cadd(a, b); v[k + half] = csub(a, b); } }
}
template <int R> __device__ __forceinline__ void dif_pass_rt(LAS f32x2* X, int sl, const f32x2 wb_in, int tid) {
    float wbx = wb_in.x, wby = wb_in.y; asm volatile("" : "+v"(wbx), "+v"(wby)); const f32x2 wb = {wbx, wby};
    const int r = tid & ((1 << sl) - 1), base = ((tid >> sl) << (sl + R)) + r;
    LAS f32x2* Xb = X + PADI(base); f32x2 v[1 << R];
#pragma unroll
    for (int k = 0; k < (1 << R); ++k) v[k] = Xb[(k << sl) + ((k << sl) >> 4)];
    dif_regs<R, false>(v, wb);
#pragma unroll
    for (int k = 0; k < (1 << R); ++k) Xb[(k << sl) + ((k << sl) >> 4)] = v[k];
}
template <int R> __device__ __forceinline__ void dit_pass_rt(LAS f32x2* X, int sl, const f32x2 wb_in, int tid) {
    float wbx = wb_in.x, wby = wb_in.y; asm volatile("" : "+v"(wbx), "+v"(wby)); const f32x2 wbig = {wbx, wby};
    const int r = tid & ((1 << sl) - 1), base = ((tid >> sl) << (sl + R)) + r;
    LAS f32x2* Xb = X + PADI(base); f32x2 v[1 << R];
#pragma unroll
    for (int k = 0; k < (1 << R); ++k) v[k] = Xb[(k << sl) + ((k << sl) >> 4)];
    dit_regs<R, false>(v, wbig);
#pragma unroll
    for (int k = 0; k < (1 << R); ++k) Xb[(k << sl) + ((k << sl) >> 4)] = v[k];
}
template <int NPT> __device__ __forceinline__ int pass_sl(int ps) { return NPT == 16 ? (ps == 0 ? 9 : ps == 1 ? 5 : 1) : (ps == 0 ? 9 : ps == 1 ? 6 : 3); }
template <int NPT> __device__ __forceinline__ void fwd2_to_lds(LAS f32x2* Xe, LAS f32x2* Xo, const f32x2* tw, int tid, f32x2* ve, f32x2* vo) {
    constexpr int R = NPT == 16 ? 4 : 3;
    asm volatile("" : "+v"(tid)); __syncthreads();
    { LAS f32x2* Pe = Xe + PADI(tid); LAS f32x2* Po = Xo + PADI(tid);
#pragma unroll
      for (int k = 0; k < NPT; ++k) { Pe[544 * k] = ve[k]; Po[544 * k] = vo[k]; } }
    __syncthreads();
#pragma nounroll
    for (int ps = 0; ps < 3; ++ps) { int sl = pass_sl<NPT>(ps); asm volatile("" : "+s"(sl));
        const f32x2 wb = tw[(tid & ((1 << sl) - 1)) << (14 - R - sl)];
        dif_pass_rt<R>(Xe, sl, wb, tid); dif_pass_rt<R>(Xo, sl, wb, tid); __syncthreads(); }
}
template <int NPT> __device__ __forceinline__ void mid_spectrum(const LAS f32x2* X, int tid, f32x2* K, float sc) {
    if (NPT == 16) {
#pragma unroll
        for (int u = 0; u < 8; ++u) { const LAS f32x2* Xb = X + PADI(2 * tid) + 1088 * u; const f32x2 a = Xb[0], b = Xb[1]; K[2 * u] = cscale(cadd(a, b), sc); K[2 * u + 1] = cscale(csub(a, b), sc); } }
    else { f32x2 w[8]; const LAS f32x2* Xb = X + PADI(8 * tid);
#pragma unroll
        for (int k = 0; k < 8; ++k) w[k] = Xb[k];
        dif_regs<3, true>(w, (f32x2){1.f, 0.f});
#pragma unroll
        for (int k = 0; k < 8; ++k) K[k] = cscale(w[k], sc); }
}
template <int NPT> __device__ __forceinline__ void mid_mul(LAS f32x2* X, int tid, const f32x2* K) {
    if (NPT == 16) {
#pragma unroll
        for (int u = 0; u < 8; ++u) { LAS f32x2* Xb = X + PADI(2 * tid) + 1088 * u; const f32x2 a = Xb[0], b = Xb[1];
            const f32x2 s = cmul(cadd(a, b), K[2 * u]), d = cmul(csub(a, b), K[2 * u + 1]); Xb[0] = cadd(s, d); Xb[1] = csub(s, d); } }
    else { f32x2 w[8]; LAS f32x2* Xb = X + PADI(8 * tid);
#pragma unroll
        for (int k = 0; k < 8; ++k) w[k] = Xb[k];
        dif_regs<3, true>(w, (f32x2){1.f, 0.f});
#pragma unroll
        for (int k = 0; k < 8; ++k) w[k] = cmul(w[k], K[k]);
        dit_regs<3, true>(w, (f32x2){1.f, 0.f});
#pragma unroll
        for (int k = 0; k < 8; ++k) Xb[k] = w[k]; }
}
template <int NPT> __device__ __forceinline__ void conv2(LAS f32x2* Xe, LAS f32x2* Xo, const f32x2* tw, int tid, f32x2* ve, f32x2* vo, const f32x2* KE, const f32x2* KO) {
    fwd2_to_lds<NPT>(Xe, Xo, tw, tid, ve, vo);
    mid_mul<NPT>(Xe, tid, KE); mid_mul<NPT>(Xo, tid, KO);
    __syncthreads();
    constexpr int R = NPT == 16 ? 4 : 3;
#pragma nounroll
    for (int ps = 2; ps >= 0; --ps) { int sl = pass_sl<NPT>(ps); asm volatile("" : "+s"(sl));
        const f32x2 wb = tw[(tid & ((1 << sl) - 1)) << (14 - R - sl)];
        dit_pass_rt<R>(Xe, sl, wb, tid); dit_pass_rt<R>(Xo, sl, wb, tid); __syncthreads(); }
    { const LAS f32x2* Pe = Xe + PADI(tid); const LAS f32x2* Po = Xo + PADI(tid);
#pragma unroll
      for (int k = 0; k < NPT; ++k) { ve[k] = Pe[544 * k]; vo[k] = Po[544 * k]; } }
}
template <int NPT>
__device__ __forceinline__ void hyena_unit(LAS unsigned char* lds, int ch, int rowbase, int nb, const float* H2, const float* w3, const float* bias, bf16_t* ST, const f32x2* T2, int tid_in) {
    constexpr int N = 512 * NPT; int tid = tid_in; asm volatile("" : "+v"(tid));
    LAS f32x2* Xe = (LAS f32x2*)lds; LAS f32x2* Xo = (LAS f32x2*)(lds + 69632); LAS float* wsm = (LAS float*)(lds + 139264);
    __syncthreads();
    if (tid < 128) wsm[tid] = w3[(tid & 63) * 1024 + (tid >> 6) * 512 + ch];
    __syncthreads();
    LAS float* FW = (LAS float*)Xe; LAS float* BW = FW + N;
    const float dmin = -3.0701134573253945f, dmax = -15.350567286626973f;
    const float delta = fabsf(dmin + (float)ch * ((dmax - dmin) / 511.0f));
    const float bs = bias[ch];
    {
      const int lane = tid & 63, wv = tid >> 6, qs = lane & 3, rr = lane >> 2;
      float wf[16], wb[16];
#pragma unroll
      for (int s4 = 0; s4 < 4; ++s4)
#pragma unroll
          for (int e = 0; e < 4; ++e) { wf[s4 * 4 + e] = wsm[4 * (qs + 4 * s4) + e]; wb[s4 * 4 + e] = wsm[64 + 4 * (qs + 4 * s4) + e]; }
      const float tsc = -delta / (float)(N - 1);
#pragma unroll 2
      for (int it = 0; it < N / 128; ++it) { const int t = wv * (N / 8) + it * 16 + rr; const f32x4* hp = (const f32x4*)(H2 + (size_t)t * 64) + qs; float af = 0.f, ab = 0.f;
#pragma unroll
          for (int s4 = 0; s4 < 4; ++s4) { const f32x4 h = hp[4 * s4];
              af = ffma_(h.x, wf[s4 * 4], af); af = ffma_(h.y, wf[s4 * 4 + 1], af); af = ffma_(h.z, wf[s4 * 4 + 2], af); af = ffma_(h.w, wf[s4 * 4 + 3], af);
              ab = ffma_(h.x, wb[s4 * 4], ab); ab = ffma_(h.y, wb[s4 * 4 + 1], ab); ab = ffma_(h.z, wb[s4 * 4 + 2], ab); ab = ffma_(h.w, wb[s4 * 4 + 3], ab); }
          af += shfl_xor_l(af, 1, lane); ab += shfl_xor_l(ab, 1, lane); af += shfl_xor_l(af, 2, lane); ab += shfl_xor_l(ab, 2, lane);
          if (qs == 0) { const float win = expf((float)t * tsc); FW[t] = af * win + (t == 0 ? bs : 0.f); BW[t] = ab * win; } } }
    __syncthreads();
    f32x2 KE[NPT], KO[NPT];
    const f32x2* tw = T2;
    const float sc = 1.0f / (2.0f * (float)N);
    { f32x2 ve[NPT], vo[NPT];
#pragma unroll
      for (int i = 0; i < NPT; ++i) { const int j = tid + 512 * i; const float fr = FW[j], br = (j == 0) ? 0.f : BW[N - j]; const f32x2 w = T2[j * (8192 / N)]; const float d = fr - br;
          ve[i] = (f32x2){fadd_(fr, br), 0.f}; vo[i] = cscale(w, d); }
      fwd2_to_lds<NPT>(Xe, Xo, tw, tid, ve, vo);
      mid_spectrum<NPT>(Xe, tid, KE, sc); mid_spectrum<NPT>(Xo, tid, KO, sc); }
    for (int p = 0; p < nb / 2; ++p) {
        bf16_t* s0 = ST + (size_t)(rowbase + 2 * p * N) * 512 + (size_t)ch * N; bf16_t* s1 = s0 + (size_t)N * 512;
        f32x2 ve[NPT], vo[NPT];
#pragma unroll
        for (int i = 0; i < NPT; ++i) { const int j = tid + 512 * i; ve[i] = (f32x2){bf2f(s0[j]), bf2f(s1[j])}; vo[i] = cmul(ve[i], T2[j * (8192 / N)]); }
        conv2<NPT>(Xe, Xo, tw, tid, ve, vo, KE, KO);
#pragma unroll
        for (int i = 0; i < NPT; ++i) { const int j = tid + 512 * i; const f32x2 y = cadd(ve[i], cmulc(vo[i], T2[j * (8192 / N)]));
            s0[j] = (bf16_t)f2bf(y.x); s1[j] = (bf16_t)f2bf(y.y); }
    }
    __syncthreads();
}

#define XB_TMO      128
#define XB_XCNT(j)  (256  + 64 * (j))
#define XB_XSUB(j)  (1280 + 64 * (j))
#define XB_XGEN(j)  (2304 + 64 * (j))
#define XB_TOP      3328
#define XB_TOPGEN   3392
#define XCD_BAR_WORDS 3456
#define XB_SPIN_CAP (1u << 18)

__device__ __forceinline__ unsigned xb_ld(unsigned* p)              { return __hip_atomic_load(p, __ATOMIC_RELAXED, __HIP_MEMORY_SCOPE_AGENT); }
__device__ __forceinline__ unsigned xb_add(unsigned* p, unsigned v) { return __hip_atomic_fetch_add(p, v, __ATOMIC_RELAXED, __HIP_MEMORY_SCOPE_AGENT); }
__device__ __forceinline__ unsigned xb_xcc_id() { return (unsigned)__builtin_amdgcn_s_getreg((3 << 11) | 20) & 0xFu; }
#define XB_SPIN(cond, bar) do { unsigned _sp = 0; while (cond) { __builtin_amdgcn_s_sleep(1); \
    if ((++_sp & 255u) == 0u) { if (xb_ld(&(bar)[XB_TMO])) break; if (_sp > XB_SPIN_CAP) { atomicAdd(&(bar)[XB_TMO], 1u); break; } } } } while (0)

struct XcdBarrier {
    unsigned* bar; unsigned x; int w;
    volatile LAS unsigned* st;
};

__device__ __forceinline__ XcdBarrier xcd_barrier_post(unsigned* bar, volatile LAS unsigned* st) {
    XcdBarrier b; b.bar = bar; b.x = xb_xcc_id(); b.st = st; b.w = __builtin_amdgcn_readfirstlane((int)threadIdx.x >> 6);
    if (threadIdx.x == 0) (void)xb_add(&bar[XB_XCNT(b.x)], 1u);
    return b;
}
__device__ __forceinline__ void xcd_barrier_complete(unsigned* bar, unsigned x, unsigned& nloc, unsigned& nx) {
    const unsigned G = gridDim.x * gridDim.y * gridDim.z;
    unsigned sum, cnt, mine, sp = 0u;
    for (;;) {
        sum = 0u; cnt = 0u; mine = 0u;
#pragma unroll
        for (unsigned j = 0; j < 16; ++j) { const unsigned c = xb_ld(&bar[XB_XCNT(j)]); sum += c; cnt += (c > 0u) ? 1u : 0u; mine = (j == x) ? c : mine; }
        if (sum == G) break;
        __builtin_amdgcn_s_sleep(1);
        if ((++sp & 255u) == 0u) { if (xb_ld(&bar[XB_TMO])) break; if (sp > XB_SPIN_CAP) { atomicAdd(&bar[XB_TMO], 1u); break; } }
    }
    nloc = mine > 0u ? mine : 1u; nx = cnt > 0u ? cnt : 1u;
}

__device__ __forceinline__ void xcd_barrier_census(const XcdBarrier& b) {
    if (b.w == 0 && fresh_lane() == 0) { unsigned nloc, nx; xcd_barrier_complete(b.bar, b.x, nloc, nx); b.st[0] = nloc; b.st[1] = nx; }
    __syncthreads();
}
__device__ __forceinline__ void xcd_barrier(const XcdBarrier& b) {
    asm volatile("s_waitcnt vmcnt(0)" ::: "memory");
    __syncthreads();
    if (b.w == 0 && fresh_lane() == 0) {
        unsigned* bar = b.bar;
        __builtin_amdgcn_s_waitcnt(0);
        unsigned nloc = b.st[0], nx = b.st[1];
        const unsigned old = xb_add(&bar[XB_XSUB(b.x)], 1u);
        const unsigned gen = old / nloc;
        if (old + 1u == (gen + 1u) * nloc) {
            __builtin_amdgcn_fence(__ATOMIC_RELEASE, "agent");
            asm volatile("s_waitcnt vmcnt(0)" ::: "memory");
            const unsigned og = xb_add(&bar[XB_TOP], 1u);
            const unsigned tg = og / nx;
            if (og + 1u == (tg + 1u) * nx) xb_add(&bar[XB_TOPGEN], 1u);
            else XB_SPIN(xb_ld(&bar[XB_TOPGEN]) == tg, bar);
            __builtin_amdgcn_fence(__ATOMIC_ACQUIRE, "agent");
            xb_add(&bar[XB_XGEN(b.x)], 1u);
            asm volatile("s_waitcnt vmcnt(0)" ::: "memory");
        } else {
            XB_SPIN(xb_ld(&bar[XB_XGEN(b.x)]) == gen, bar);
            __builtin_amdgcn_fence(__ATOMIC_ACQUIRE, "agent");
            asm volatile("s_waitcnt vmcnt(0)" ::: "memory");
        }
    }
    __syncthreads();
}


#ifndef PROBE_SKIP
#define PROBE_SKIP 0
#endif
constexpr int NPASS = PROBE_SKIP ? 2 : 1;
#define DO(bit) (pass == NPASS - 1 || !(PROBE_SKIP & (bit)))
struct Params { const float* in[30]; float* out; unsigned char* ws; };

__global__ void __launch_bounds__(512, 2) mk_fwd(Params p) {
    extern __shared__ __attribute__((aligned(16))) unsigned char lds_raw[];
    cg::grid_group grid = cg::this_grid();
    LAS unsigned char* lds = (LAS unsigned char*)lds_raw;
    Ctx c; c.wave = __builtin_amdgcn_readfirstlane((int)threadIdx.x >> 6); c.G = gridDim.x; c.bid = blockIdx.x;
    unsigned char* ws = p.ws; float* x = p.out;
    { volatile LAS unsigned* st = (volatile LAS unsigned*)(lds + LDS_BYTES - 16); if (threadIdx.x < 4) st[threadIdx.x] = 0u; }
    __syncthreads();
    const XcdBarrier xbar = xcd_barrier_post((unsigned*)(p.ws + WS_BAR), (volatile LAS unsigned*)(lds + LDS_BYTES - 16));
#define WB ((bf16_t*)(ws + WS_W))
#define XN ((bf16_t*)(ws + WS_XN))
#define BIG ((bf16_t*)(ws + WS_BIG))
#define ST ((bf16_t*)(ws + WS_ST))
#define QH ((bf16_t*)(ws + WS_QH))
#define KVH ((bf16_t*)(ws + WS_KVH))
#define MG ((bf16_t*)(ws + WS_MG))
#define PB ((bf16_t*)(ws + WS_PB))
#define T2 ((const f32x2*)(ws + WS_T2))
#define tabA ((const f32x2*)(ws + WS_TABA))
#define tabM ((const f32x2*)(ws + WS_TABM))
#define SSQ(i) ((float*)(ws + WS_W + WO_END * 2) + (size_t)(i) * MT)
#define LAUNDER() asm volatile("" : "+s"(c.bid), "+s"(c.G), "+s"(ws), "+s"(x))
#define SYNC() do { xcd_barrier(xbar); LAUNDER(); } while (0)
#define SYNC_CG() do { grid.sync(); LAUNDER(); } while (0)
    for (int pass = 0; pass < NPASS; ++pass) {
    misc_tables(c, ws, p.in[12], p.in[13], p.in[14], p.in[15], p.in[17]);

#define GEMMX(BIT, EPI, Aptr, LDA, Bptr, NN, KK, ...) do { if (!DO(BIT)) break; pg8::Gemm g_{(const bf16_t*)(Aptr), (const bf16_t*)(Bptr), MT, NN, KK, LDA}; pg8::StaticOrder S_; S_.init(MT, NN, c.G, c.bid); \
        EPI E_{__VA_ARGS__}; pg8::gemm_phase<EPI>(lds, g_, S_, E_, c.wave); } while (0)
#define GEMM(...) GEMMX(2, __VA_ARGS__)
#define GEMMF(...) GEMMX(16, __VA_ARGS__)

    for (int l = 0; l < 2; ++l) {
        LAUNDER();
        { LayerW w; w.gate1 = p.in[3] + (size_t)l * DM * DFF; w.up1 = p.in[4] + (size_t)l * DM * DFF; w.dn1 = p.in[5] + (size_t)l * DFF * DM; w.win = p.in[7] + (size_t)l * DM * 5792;
          w.uq = p.in[20] + (size_t)l * 256 * 768; w.ukv = p.in[22] + (size_t)l * 128 * 1024; w.br = p.in[23] + (size_t)l * 3 * 512 * 1024; w.wout = p.in[24] + (size_t)l * DM * DM;
          w.gate2 = p.in[26] + (size_t)l * DM * DFF; w.up2 = p.in[27] + (size_t)l * DM * DFF; w.dn2 = p.in[28] + (size_t)l * DFF * DM;
          if (DO(8)) convert_weights(c, w, WB, lds); }
        if (l == 0 && DO(8)) norm_rows<1>(c, p.in[0], p.in[1], x, p.in[2], XN);
        if (l == 0) { SYNC_CG(); xcd_barrier_census(xbar); } else SYNC();
        const float* ssA = l == 0 ? nullptr : SSQ(0);
        float* ssMix = SSQ(0); float* ssF2 = SSQ(0);
        GEMMF(pg8::EpiSwiglu, XN, DM, WB + WO_GU1, 5632, DM, BIG, DFF, ssA);
        SYNC();
        GEMMF(pg8::EpiResid<1>, BIG, DFF, WB + WO_DN1, DM, DFF, x, p.in[6] + l * DM, XN, ssMix, (LAS float*)(lds + 131072), l == 0 ? p.in[0] : nullptr, l == 0 ? p.in[1] : nullptr);
        SYNC();
        GEMM(pg8::EpiStore, XN, DM, WB + WO_IN, ZCW, DM, BIG, ZCW, ssMix);
        SYNC();
        if (DO(8)) tok_local(c, BIG, p.in[8] + l * 64, p.in[9] + l * 64, p.in[19] + l * 256, p.in[21] + l * 128, tabA, tabM);
        if (DO(8)) hy_fwd_tiles(c, BIG, ST, p.in[10] + (size_t)l * 3 * 1536, p.in[11] + l * 1536, lds);
        SYNC();
        GEMM(pg8::EpiStore, BIG + C_CQ, ZCW, WB + WO_UQ, 768, 256, QH, 768, nullptr);
        GEMM(pg8::EpiStore, BIG + C_CKV, ZCW, WB + WO_UKV, 1024, 128, KVH, 1024, nullptr);
        __syncthreads();
        { const float* H2l = (const float*)(ws + WS_H2 + (size_t)l * 3 * MiB); const float* w3 = p.in[16] + (size_t)l * 64 * 1024; const float* hb = p.in[18] + l * 512;
          if (DO(4)) for (int u = c.bid; u < 1024; u += c.G) {
              if (u < 512) hyena_unit<16>(lds, u, 0, 8, H2l, w3, hb, ST, T2, c.wave * 64 + fresh_lane());
              else hyena_unit<8>(lds, u - 512, MP, 4, H2l + 8192 * 64, w3, hb, ST, T2, c.wave * 64 + fresh_lane()); } }
        __syncthreads();
        if (DO(1)) for (int i = 0;; ++i) { const int u = i * c.G + CTX_VCU(c); if (u >= 2560) break;
            int rowbase, qb, h, L;
            if (u < 2048) { qb = u & 31; h = (u >> 5) & 7; rowbase = (u >> 8) * LP; L = LP; } else { const int v = u - 2048; qb = v & 15; h = (v >> 4) & 7; rowbase = MP + (v >> 7) * LS; L = LS; }
            bf16_t* Qb = BIG + (size_t)(rowbase + qb * 256) * ZCW + C_Q + h * 64; const bf16_t* Kb = BIG + (size_t)rowbase * ZCW + C_K + (h >> 2) * 64; const bf16_t* Vb = BIG + (size_t)rowbase * ZCW + C_V + (h >> 2) * 64;
            att::attn_unit<4>(Qb, ZCW, Kb, ZCW, nullptr, 0, Vb, ZCW, Qb, ZCW, L, (char*)lds_raw, 0, nullptr, c.wave); }
        SYNC();
        if (DO(1)) for (int i = 0;; ++i) { const int u = i * c.G + CTX_VCU(c); if (u >= 2560) break;
            int rowbase, qb, h, L;
            if (u < 2048) { qb = u & 31; h = (u >> 5) & 7; rowbase = (u >> 8) * LP; L = LP; } else { const int v = u - 2048; qb = v & 15; h = (v >> 4) & 7; rowbase = MP + (v >> 7) * LS; L = LS; }
            const bf16_t* Qb = QH + (size_t)(rowbase + qb * 256) * 768 + h * 96; const bf16_t* K1 = KVH + (size_t)rowbase * 1024 + h * 128; const bf16_t* K2 = BIG + (size_t)rowbase * ZCW + C_KR;
            const bf16_t* Vb = K1 + 64; bf16_t* Ob = BIG + (size_t)(rowbase + qb * 256) * ZCW + C_YC + h * 64;
            att::attn_unit<6>(Qb, 768, K1, 1024, K2, ZCW, Vb, 1024, Ob, ZCW, L, (char*)lds_raw, qb * 256, tabM, c.wave); }
        if (DO(8)) hy_bwd_tiles(c, BIG, ST, p.in[10] + (size_t)l * 3 * 1536, p.in[11] + l * 1536, lds);
        SYNC();
        GEMM(pg8::EpiStore, BIG + C_Q, ZCW, WB + WO_BR, DM, 512, MG, DM, nullptr);
        GEMM(pg8::EpiGate<0>, XN, DM, WB + WO_GATE, DM, DM, MG, MG, ssMix);
        GEMM(pg8::EpiStore, BIG + C_YB, ZCW, WB + WO_BR + (size_t)1024 * 512, DM, 512, PB, DM, nullptr);
        GEMM(pg8::EpiGate<1>, XN, DM, WB + WO_GATE + (size_t)1024 * 1024, DM, DM, MG, PB, ssMix);
        GEMM(pg8::EpiStore, BIG + C_YC, ZCW, WB + WO_BR + (size_t)2 * 1024 * 512, DM, 512, PB, DM, nullptr);
        GEMM(pg8::EpiGate<1>, XN, DM, WB + WO_GATE + (size_t)2 * 1024 * 1024, DM, DM, MG, PB, ssMix);
        SYNC();
        GEMM(pg8::EpiResid<0>, MG, DM, WB + WO_OUT, DM, DM, x, p.in[25] + l * DM, XN, ssF2, (LAS float*)(lds + 131072), nullptr, nullptr);
        SYNC();
        GEMMF(pg8::EpiSwiglu, XN, DM, WB + WO_GU2, 5632, DM, BIG, DFF, ssF2);
        SYNC();
        GEMMF(pg8::EpiResid<1>, BIG, DFF, WB + WO_DN2, DM, DFF, x, l == 0 ? p.in[2] + DM : nullptr, XN, SSQ(0), (LAS float*)(lds + 131072), nullptr, nullptr);
        SYNC();
    }
    norm_rows<2>(c, nullptr, nullptr, x, p.in[29], nullptr);
    if (pass + 1 < NPASS) SYNC();
    }
}

extern "C" void kernel_launch(void* const* d_in, const int* in_sizes, int n_in, void* d_out, int out_size, void* d_ws, size_t ws_size, hipStream_t stream) {
    static int grid = 0;
    if (grid == 0) {
        if (n_in != 30 || out_size != MT * DM || ws_size < WS_END) { fprintf(stderr, "kernel_launch: unexpected shapes: n_in %d out %d ws %zu\n", n_in, out_size, ws_size); grid = -1; return; }
        int dev = 0, cus = 0, per_cu = 0;
        hipGetDevice(&dev); hipDeviceGetAttribute(&cus, hipDeviceAttributeMultiprocessorCount, dev);
        if (hipFuncSetAttribute((const void*)mk_fwd, hipFuncAttributeMaxDynamicSharedMemorySize, LDS_BYTES) != hipSuccess) { fprintf(stderr, "kernel_launch: hipFuncSetAttribute failed\n"); grid = -1; return; }
        hipOccupancyMaxActiveBlocksPerMultiprocessor(&per_cu, (const void*)mk_fwd, 512, LDS_BYTES);
        if (per_cu < 1) { fprintf(stderr, "kernel_launch: occupancy query says %d\n", per_cu); per_cu = 1; }
        (void)hipGetLastError();
        grid = cus * 1;
    }
    if (grid < 0) return;
    if (hipMemsetAsync((char*)d_ws + WS_BAR, 0, 16384, stream) != hipSuccess) { fprintf(stderr, "kernel_launch: memset failed\n"); return; }
    Params p{};
    for (int i = 0; i < 30; ++i) p.in[i] = (const float*)d_in[i];
    p.out = (float*)d_out; p.ws = (unsigned char*)d_ws;
    void* args[] = {&p};
    hipError_t e = hipLaunchCooperativeKernel((const void*)mk_fwd, dim3(grid), dim3(512), args, LDS_BYTES, stream);
    if (e != hipSuccess) fprintf(stderr, "cooperative launch failed: %s (grid %d)\n", hipGetErrorString(e), grid);
}
```

```cpp
#include <hip/hip_runtime.h>
#include <hip/hip_bf16.h>
#include <hip/hip_cooperative_groups.h>
#include <cstdio>
#include <cstdint>
namespace cg = cooperative_groups;

#define LAS __attribute__((address_space(3)))
typedef unsigned short bf16_t;
typedef short bf16x8 __attribute__((ext_vector_type(8)));
typedef short s16x4 __attribute__((ext_vector_type(4)));
typedef float f32x4 __attribute__((ext_vector_type(4)));
typedef float f32x2 __attribute__((ext_vector_type(2)));
typedef float f32x16 __attribute__((ext_vector_type(16)));
typedef unsigned u32x4 __attribute__((ext_vector_type(4)));
typedef unsigned u32x2 __attribute__((ext_vector_type(2)));

constexpr int DM = 1024, DFF = 2816, MP = 65536, MS = 16384, MT = MP + MS;
constexpr int LP = 8192, LS = 4096;
constexpr int ZCW = 2816;
constexpr int C_Q = 0, C_K = 512, C_V = 640, C_HY = 768, C_CQ = 2304, C_CKV = 2560, C_KR = 2688;
constexpr int C_YB = 1280, C_YC = 1792;
constexpr float EPS = 1e-6f;
constexpr size_t MiB = 1u << 20;
constexpr size_t WS_T2 = 0, WS_TABA = 64 * 1024, WS_TABM = 80 * 1024, WS_H2 = 1 * MiB;
constexpr size_t WS_BAR = 7 * MiB;
constexpr size_t WS_W = 8 * MiB;
constexpr size_t WS_XN = 60 * MiB;
constexpr size_t WS_BIG = 220 * MiB;
constexpr size_t WS_R2 = 660 * MiB;
constexpr size_t WS_ST = WS_R2;
constexpr size_t WS_QH = WS_R2 + 80 * MiB;
constexpr size_t WS_KVH = WS_R2 + 200 * MiB;
constexpr size_t WS_MG = WS_R2;
constexpr size_t WS_PB = WS_R2 + 160 * MiB;
constexpr size_t WS_END = 1024 * MiB;
constexpr size_t WO_GU1 = 0, WO_DN1 = WO_GU1 + 5632 * 1024, WO_IN = WO_DN1 + 1024 * 2816, WO_GATE = WO_IN + 2816 * 1024, WO_UQ = WO_GATE + 3072 * 1024,
                 WO_UKV = WO_UQ + 768 * 256, WO_BR = WO_UKV + 1024 * 128, WO_OUT = WO_BR + 3 * 1024 * 512, WO_GU2 = WO_OUT + 1024 * 1024, WO_DN2 = WO_GU2 + 5632 * 1024,
                 WO_END = WO_DN2 + 1024 * 2816;
static_assert(WO_END * 2 + 5 * (size_t)MT * 4 <= 52 * MiB, "weights + row statistics fit");
constexpr int LDS_BYTES = 139264 + 2048;

__device__ __forceinline__ int fresh_lane() { int l; asm volatile("v_mbcnt_lo_u32_b32 %0, -1, 0\n\tv_mbcnt_hi_u32_b32 %0, -1, %0" : "=v"(l)); return l; }
__device__ __forceinline__ int fresh_tid(int wave) { return wave * 64 + fresh_lane(); }
__device__ __forceinline__ float bf2f(unsigned h) { return __uint_as_float(h << 16); }
__device__ __forceinline__ unsigned f2bf(float f) { unsigned u = __float_as_uint(f); return (u + 0x7fffu + ((u >> 16) & 1u)) >> 16; }
__device__ __forceinline__ unsigned pk2(float lo, float hi) { return f2bf(lo) | (f2bf(hi) << 16); }
typedef __bf16 bf16x2_t_ __attribute__((ext_vector_type(2)));
__device__ __forceinline__ unsigned cvt_pk_bf16(float lo, float hi) { f32x2 v = {lo, hi}; bf16x2_t_ b = __builtin_convertvector(v, bf16x2_t_); return __builtin_bit_cast(unsigned, b); }
__device__ __forceinline__ float shfl_xor_l(float v, int o, int lane) { return __int_as_float(__builtin_amdgcn_ds_bpermute((lane ^ o) << 2, __float_as_int(v))); }
__device__ __forceinline__ float bcast_l(float v, int src) { return __int_as_float(__builtin_amdgcn_readlane(__float_as_int(v), src)); }
__device__ __forceinline__ float wave_sum(float v, int lane) {
#pragma unroll
    for (int o = 1; o < 64; o <<= 1) v += shfl_xor_l(v, o, lane);
    return v;
}
__device__ __forceinline__ float sigmoidf_(float x) { return __builtin_amdgcn_rcpf(1.0f + __builtin_amdgcn_exp2f(-1.4426950408889634f * x)); }

namespace pg8 {
constexpr int BM = 256, BK = 64, HALF = 128, HTB = HALF * BK * 2, STAGE_BYTES = 8 * HTB, NXCD = 8, WGM = 8;
__host__ __device__ __forceinline__ int lds_byte(int r, int c) { const int st = (r >> 4) * 2 + (c >> 5), rr = r & 15, cc = c & 31, ob = rr * 64 + cc * 2; return st * 1024 + (ob ^ (((ob >> 9) & 1) << 5)); }
__host__ __device__ __forceinline__ void stage_rc(int b, int& R, int& C) { const int st = b / 1024, sb = b % 1024, swz = sb ^ (((sb >> 9) & 1) << 5); R = (st >> 1) * 16 + swz / 64; C = (st & 1) * 32 + (swz % 64) / 2; }
__host__ __device__ __forceinline__ int perm32(int rho) { const int n = rho >> 4, i = rho & 15; return 8 * (i >> 2) + 4 * n + (i & 3); }
struct Unit { int pm, pn; };
struct Gemm { const bf16_t* A; const bf16_t* Bt; int M, N, K, lda; };
struct StaticOrder {
    int nM, nN, nwg, G, c;
    __device__ void init(int M, int N, int G_, int c_) { nM = M / BM; nN = N / BM; nwg = nM * nN; G = G_; c = c_; }
    __device__ bool next(int i, Unit& u) const {
        const long L = (long)i * G + c; if (L >= nwg) return false;
        int wgid = (int)L; { const int q = nwg / NXCD, r = nwg % NXCD, xcd = wgid % NXCD, off = wgid / NXCD; wgid = (xcd < r ? xcd * (q + 1) : r * (q + 1) + (xcd - r) * q) + off; }
        const int nig = WGM * nN, gid = wgid / nig, fm = gid * WGM, gsz = (nM - fm) < WGM ? (nM - fm) : WGM;
        u.pm = fm + ((wgid % nig) % gsz); u.pn = (wgid % nig) / gsz; return true;
    }
};
typedef f32x4 Acc[2][2][4][2];

struct EpiStore {
    bf16_t* O; int ldc; const float* ss;
    __device__ __forceinline__ void operator()(const Acc& acc, const Unit& u, int wr, int wc, int fr, int fq) const {
        const int row0 = u.pm * BM + wr * 64 + fr, col0 = u.pn * BM + wc * 32 + 8 * fq;
#pragma unroll
        for (int ai = 0; ai < 2; ++ai)
#pragma unroll
            for (int m = 0; m < 4; ++m) { const int row = row0 + ai * HALF + m * 16; bf16_t* rowp = O + (size_t)row * ldc + col0;
                const float rs = ss ? __builtin_amdgcn_rsqf(((ss[row] + ss[MT + row]) + (ss[2 * MT + row] + ss[3 * MT + row])) * (1.f / DM) + EPS) : 1.f;
#pragma unroll
                for (int bj = 0; bj < 2; ++bj) { const f32x4 v0 = acc[ai][bj][m][0] * rs, v1 = acc[ai][bj][m][1] * rs;
                    u32x4 w; w.x = cvt_pk_bf16(v0[0], v0[1]); w.y = cvt_pk_bf16(v0[2], v0[3]); w.z = cvt_pk_bf16(v1[0], v1[1]); w.w = cvt_pk_bf16(v1[2], v1[3]);
                    *(u32x4*)(rowp + bj * HALF) = w; } }
    }
};
struct EpiSwiglu {
    bf16_t* O; int ldc; const float* ss;
    __device__ __forceinline__ void operator()(const Acc& acc, const Unit& u, int wr, int wc, int fr, int fq) const {
        const int row0 = u.pm * BM + wr * 64 + fr, col0 = u.pn * HALF + wc * 32 + 8 * fq;
#pragma unroll
        for (int ai = 0; ai < 2; ++ai)
#pragma unroll
            for (int m = 0; m < 4; ++m) { const int row = row0 + ai * HALF + m * 16; bf16_t* rowp = O + (size_t)row * ldc + col0;
                const float rs = ss ? __builtin_amdgcn_rsqf(((ss[row] + ss[MT + row]) + (ss[2 * MT + row] + ss[3 * MT + row])) * (1.f / DM) + EPS) : 1.f;
                float h[8];
#pragma unroll
                for (int n = 0; n < 2; ++n)
#pragma unroll
                    for (int j = 0; j < 4; ++j) { const float g = acc[ai][0][m][n][j] * rs, up = acc[ai][1][m][n][j] * rs; h[n * 4 + j] = g * sigmoidf_(g) * up; }
                u32x4 w; w.x = cvt_pk_bf16(h[0], h[1]); w.y = cvt_pk_bf16(h[2], h[3]); w.z = cvt_pk_bf16(h[4], h[5]); w.w = cvt_pk_bf16(h[6], h[7]);
                *(u32x4*)rowp = w; }
    }
};
template <int HALFA> struct EpiResid {
    float* X_; const float* gnext_; bf16_t* XNo_; float* ss_; LAS float* part_;
    __device__ __forceinline__ void operator()(const Acc& acc, const Unit& u, int wr, int wc, int fr, int fq) const {
        float* const X = X_; const float alpha = HALFA ? 0.5f : 1.0f; const float* const gnext = gnext_; bf16_t* const XNo = XNo_; float* const ss = ss_; LAS float* const part = part_;
        const int row0 = u.pm * BM + wr * 64 + fr, col0 = u.pn * BM + wc * 32 + 8 * fq; const int lane = fr + 16 * fq;
        f32x4 gv[2][2];
        if (gnext) {
#pragma unroll
            for (int bj = 0; bj < 2; ++bj)
#pragma unroll
                for (int n = 0; n < 2; ++n) gv[bj][n] = *(const f32x4*)(gnext + col0 + bj * HALF + 4 * n); }
#pragma unroll
        for (int ai = 0; ai < 2; ++ai)
#pragma unroll
            for (int m = 0; m < 4; ++m) { const int row = row0 + ai * HALF + m * 16; float* rowp = X + (size_t)row * DM + col0; float sq = 0.f;
#pragma unroll
                for (int bj = 0; bj < 2; ++bj) { f32x4* p0 = (f32x4*)(rowp + bj * HALF); const f32x4 o0 = p0[0] + acc[ai][bj][m][0] * alpha, o1 = p0[1] + acc[ai][bj][m][1] * alpha; p0[0] = o0; p0[1] = o1;
                    if (gnext) { sq += (o0[0] * o0[0] + o0[1] * o0[1]) + (o0[2] * o0[2] + o0[3] * o0[3]) + (o1[0] * o1[0] + o1[1] * o1[1]) + (o1[2] * o1[2] + o1[3] * o1[3]);
                        const f32x4 y0 = o0 * gv[bj][0], y1 = o1 * gv[bj][1];
                        u32x4 w; w.x = cvt_pk_bf16(y0[0], y0[1]); w.y = cvt_pk_bf16(y0[2], y0[3]); w.z = cvt_pk_bf16(y1[0], y1[1]); w.w = cvt_pk_bf16(y1[2], y1[3]);
                        *(u32x4*)(XNo + (size_t)row * DM + col0 + bj * HALF) = w; } }
                if (gnext) { sq += shfl_xor_l(sq, 16, lane); sq += shfl_xor_l(sq, 32, lane); if (fq == 0) part[wc * 256 + ai * HALF + wr * 64 + m * 16 + fr] = sq; }
                asm volatile("" ::: "memory"); }
        if (gnext) {
            asm volatile("s_waitcnt lgkmcnt(0)" ::: "memory"); __builtin_amdgcn_s_barrier(); asm volatile("" ::: "memory");
            const int t = (wr * 4 + wc) * 64 + lane;
            if (t < 256) ss[(size_t)u.pn * MT + u.pm * BM + t] = (part[t] + part[256 + t]) + (part[512 + t] + part[768 + t]);
        }
    }
};
template <int ACCUM> struct EpiGate {
    bf16_t* MG; const bf16_t* PB; const float* ss;
    __device__ __forceinline__ void operator()(const Acc& acc, const Unit& u, int wr, int wc, int fr, int fq) const {
        const int row0 = u.pm * BM + wr * 64 + fr, col0 = u.pn * BM + wc * 32 + 8 * fq;
#pragma unroll
        for (int ai = 0; ai < 2; ++ai)
#pragma unroll
            for (int m = 0; m < 4; ++m) { const int row = row0 + ai * HALF + m * 16; const size_t ro = (size_t)row * DM + col0; const float rs = __builtin_amdgcn_rsqf(((ss[row] + ss[MT + row]) + (ss[2 * MT + row] + ss[3 * MT + row])) * (1.f / DM) + EPS);
#pragma unroll
                for (int bj = 0; bj < 2; ++bj) { const u32x4 pb = *(const u32x4*)(PB + ro + bj * HALF); u32x4 old = {0u, 0u, 0u, 0u};
                    if (ACCUM) old = *(const u32x4*)(MG + ro + bj * HALF);
                    float r[8];
#pragma unroll
                    for (int e = 0; e < 8; ++e) { const float a = acc[ai][bj][m][e >> 2][e & 3] * rs; const unsigned pw = pb[e >> 1], ow = old[e >> 1];
                        const float pv = (e & 1) ? __uint_as_float(pw & 0xffff0000u) : __uint_as_float(pw << 16);
                        const float ov = (e & 1) ? __uint_as_float(ow & 0xffff0000u) : __uint_as_float(ow << 16);
                        r[e] = sigmoidf_(a) * pv + (ACCUM ? ov : 0.f); }
                    u32x4 w; w.x = cvt_pk_bf16(r[0], r[1]); w.y = cvt_pk_bf16(r[2], r[3]); w.z = cvt_pk_bf16(r[4], r[5]); w.w = cvt_pk_bf16(r[6], r[7]);
                    *(u32x4*)(MG + ro + bj * HALF) = w; } }
    }
};

__device__ __forceinline__ void glds16_s(const void* sbase, unsigned voff, unsigned lds_dst) { unsigned keep;
    asm volatile("s_mov_b32 %0, m0\n\ts_mov_b32 m0, %3\n\ts_nop 0\n\tglobal_load_lds_dwordx4 %1, %2\n\ts_mov_b32 m0, %0" : "=&s"(keep) : "v"(voff), "s"(sbase), "s"(lds_dst) : "memory"); }
template <class Epi>
__device__ __forceinline__ void gemm_phase(LAS unsigned char* lds, const Gemm g, const StaticOrder& S, const Epi& E, int wave) {
    const int tid = fresh_tid(wave), wid = wave, lane = tid & 63, wr = wid >> 2, wc = wid & 3, fr = lane & 15, fq = lane >> 4;
    const int K = g.K, nt = K / BK, lda = g.lda;
    unsigned voffA[2], voffB[2];
#pragma unroll
    for (int i = 0; i < 2; ++i) { int R, C; stage_rc(tid * 16 + i * 8192, R, C); const int Rb = (R & ~31) + perm32(R & 31);
        voffA[i] = (unsigned)(R * lda + C) * 2u; voffB[i] = (unsigned)(Rb * K + C) * 2u; }
    const size_t kstep = (size_t)(BK * 2);
    const size_t hstepA = (size_t)HALF * lda * 2, hstepB = (size_t)HALF * K * 2;
    const size_t tstepA = 2 * hstepA, tstepB = 2 * hstepB;
    const unsigned ldsw = (unsigned)wid * 1024u; const unsigned lds0 = (unsigned)(__UINTPTR_TYPE__)lds;
    const int aoff = lds_byte(wr * 64 + fr, fq * 8), boff = lds_byte(wc * 32 + fr, fq * 8);
#define PG8_SA(b, h) (((b) * 2 + (h)) * HTB)
#define PG8_SB(b, h) ((4 + (b) * 2 + (h)) * HTB)
#define PG8_STAGE(bufoff, gbase, voff) do { _Pragma("unroll") for (int _i = 0; _i < 2; ++_i) \
        glds16_s((const void*)(gbase), (voff)[_i], lds0 + (unsigned)((bufoff) + _i * 8192) + ldsw); } while (0)
#define PG8_LDA(dst, b, h) do { _Pragma("unroll") for (int m = 0; m < 4; ++m) _Pragma("unroll") for (int k = 0; k < 2; ++k) dst[m][k] = *(const LAS bf16x8*)(lds + PG8_SA(b, h) + aoff + m * 2048 + k * 1024); } while (0)
#define PG8_LDB(dst, b, h) do { _Pragma("unroll") for (int n = 0; n < 2; ++n) _Pragma("unroll") for (int k = 0; k < 2; ++k) dst[n][k] = *(const LAS bf16x8*)(lds + PG8_SB(b, h) + boff + n * 2048 + k * 1024); } while (0)
#define PG8_MMA(ai, bj, At, Bt) do { __builtin_amdgcn_s_setprio(1); _Pragma("unroll") for (int m = 0; m < 4; ++m) _Pragma("unroll") for (int n = 0; n < 2; ++n) _Pragma("unroll") for (int k = 0; k < 2; ++k) \
        acc[ai][bj][m][n] = __builtin_amdgcn_mfma_f32_16x16x32_bf16(Bt[n][k], At[m][k], acc[ai][bj][m][n], 0, 0, 0); __builtin_amdgcn_s_setprio(0); } while (0)
#define PG8_WAIT_V(n) asm volatile("s_waitcnt vmcnt(" #n ")" ::: "memory")
#define PG8_WAIT_L(n) asm volatile("s_waitcnt lgkmcnt(" #n ")" ::: "memory")
#define PG8_BAR __builtin_amdgcn_s_barrier()
#define PG8_SCHED __builtin_amdgcn_sched_barrier(0)
    Unit cur, nxt; int ui = 0;
    if (!S.next(0, cur)) return;
    float zf = 0.f; asm volatile("" : "+v"(zf));
    Acc acc;
#pragma unroll
    for (int a = 0; a < 2; ++a)
#pragma unroll
        for (int b = 0; b < 2; ++b)
#pragma unroll
            for (int m = 0; m < 4; ++m)
#pragma unroll
                for (int n = 0; n < 2; ++n) acc[a][b][m][n] = (f32x4){zf, zf, zf, zf};
    bf16x8 At[4][2], B0[2][2], B1[2][2];
    const char* cA = (const char*)g.A + (size_t)cur.pm * tstepA; const char* cB = (const char*)g.Bt + (size_t)cur.pn * tstepB;
    PG8_STAGE(PG8_SB(0, 0), cB, voffB); PG8_STAGE(PG8_SB(0, 1), cB + hstepB, voffB); PG8_STAGE(PG8_SA(0, 0), cA, voffA); PG8_STAGE(PG8_SA(0, 1), cA + hstepA, voffA);
    if (wr == 1) PG8_BAR;
    PG8_WAIT_V(2); PG8_BAR;
    PG8_STAGE(PG8_SB(1, 0), cB + kstep, voffB); PG8_STAGE(PG8_SA(1, 0), cA + kstep, voffA); PG8_STAGE(PG8_SB(1, 1), cB + hstepB + kstep, voffB);
    PG8_WAIT_V(6); PG8_BAR;
    for (;;) {
        const bool has_next = S.next(ui + 1, nxt);
        const char* nA = has_next ? (const char*)g.A + (size_t)nxt.pm * tstepA : cA; const char* nB = has_next ? (const char*)g.Bt + (size_t)nxt.pn * tstepB : cB;
        for (int t = 0; t < nt; t += 2) {
            const bool last = (t == nt - 2);
            const char* a1 = cA + (size_t)(t + 1) * kstep;
            const char* a2 = last ? nA : cA + (size_t)(t + 2) * kstep; const char* b2 = last ? nB : cB + (size_t)(t + 2) * kstep;
            const char* a3 = a2 + kstep; const char* b3 = b2 + kstep;
            PG8_LDB(B0, 0, 0); PG8_LDB(B1, 0, 1); PG8_SCHED; PG8_LDA(At, 0, 0); PG8_STAGE(PG8_SA(1, 1), a1 + hstepA, voffA);
            PG8_WAIT_V(8); PG8_WAIT_L(0); PG8_BAR; PG8_MMA(0, 0, At, B0); PG8_MMA(0, 1, At, B1); PG8_BAR; PG8_SCHED;
            PG8_LDA(At, 0, 1); PG8_STAGE(PG8_SB(0, 0), b2, voffB); PG8_STAGE(PG8_SB(0, 1), b2 + hstepB, voffB); PG8_STAGE(PG8_SA(0, 0), a2, voffA);
            PG8_WAIT_V(8); PG8_WAIT_L(0); PG8_BAR; PG8_MMA(1, 0, At, B0); PG8_MMA(1, 1, At, B1); PG8_BAR; PG8_SCHED;
            PG8_LDB(B0, 1, 0); PG8_LDB(B1, 1, 1); PG8_SCHED; PG8_LDA(At, 1, 0); PG8_STAGE(PG8_SA(0, 1), a2 + hstepA, voffA);
            PG8_WAIT_V(8); PG8_WAIT_L(0); PG8_BAR; PG8_MMA(0, 0, At, B0); PG8_MMA(0, 1, At, B1); PG8_BAR; PG8_SCHED;
            PG8_LDA(At, 1, 1); PG8_STAGE(PG8_SB(1, 0), b3, voffB); PG8_STAGE(PG8_SB(1, 1), b3 + hstepB, voffB); PG8_STAGE(PG8_SA(1, 0), a3, voffA);
            PG8_WAIT_V(8); PG8_WAIT_L(0); PG8_BAR; PG8_MMA(1, 0, At, B0); PG8_MMA(1, 1, At, B1); PG8_BAR; PG8_SCHED;
        }
        if (wr == 0) PG8_BAR;
        { const int l2 = fresh_lane(); E(acc, cur, wr, wc, l2 & 15, l2 >> 4); }
        if (!has_next) break;
#pragma unroll
        for (int a = 0; a < 2; ++a)
#pragma unroll
            for (int b = 0; b < 2; ++b)
#pragma unroll
                for (int m = 0; m < 4; ++m)
#pragma unroll
                    for (int n = 0; n < 2; ++n) acc[a][b][m][n] = (f32x4){zf, zf, zf, zf};
        cur = nxt; cA = nA; cB = nB; ++ui;
        if (wr == 1) PG8_BAR;
    }
    PG8_WAIT_V(0);
    PG8_BAR;
#undef PG8_SA
#undef PG8_SB
#undef PG8_STAGE
#undef PG8_LDA
#undef PG8_LDB
#undef PG8_MMA
#undef PG8_WAIT_V
#undef PG8_WAIT_L
#undef PG8_BAR
#undef PG8_SCHED
}
}

namespace att {
typedef __bf16 bf16x2_t __attribute__((ext_vector_type(2)));
__device__ __forceinline__ unsigned cvtpk_s(float lo, float hi) { f32x2 v = {lo, hi}; bf16x2_t b = __builtin_convertvector(v, bf16x2_t); return __builtin_bit_cast(unsigned, b); }
constexpr int NW = 8, QBLK = 32, KVBLK = 64;
constexpr float THR = 8.f;
constexpr int SHM_V = 16384, SHM_K = 16384;
#define KSWZ(row, colB) ((row) * 256 + ((colB) ^ (((row) & 7) << 4)))
#define SBAR() __builtin_amdgcn_sched_barrier(0)
__device__ __forceinline__ int crow(int r, int hi) { return (r & 3) + 8 * (r >> 2) + 4 * hi; }
template <int DKB> struct Sc { static constexpr float SCALE = DKB == 4 ? 0.125f : 0.10206207261596575f; };

constexpr float THR2 = 11.5f;
__device__ __forceinline__ float rowmax32(const f32x16& p0, const f32x16& p1) {
  float pmax = p0[0];
#pragma unroll
  for (int r = 1; r < 16; ++r) pmax = fmaxf(pmax, p0[r]);
#pragma unroll
  for (int r = 0; r < 16; ++r) pmax = fmaxf(pmax, p1[r]);
  auto rr = __builtin_amdgcn_permlane32_swap(__float_as_uint(pmax), __float_as_uint(pmax), false, false);
  return fmaxf(__uint_as_float(rr[0]), __uint_as_float(rr[1]));
}
template <bool FIRST> __device__ __forceinline__ void partialSM(f32x16& p0, f32x16& p1, float& m_reg, f32x16& negm, float& alpha) {
  const float pmax = rowmax32(p0, p1);
  alpha = 1.f;
  if (FIRST) { m_reg = pmax; p0 = p0 - pmax; p1 = p1 - pmax;
#pragma unroll
    for (int r = 0; r < 16; ++r) negm[r] = -m_reg; }
  else if (__builtin_expect(!__all(pmax <= THR2), 0)) { const float dl = fmaxf(pmax, 0.f); m_reg += dl; p0 = p0 - dl; p1 = p1 - dl; alpha = __builtin_amdgcn_exp2f(-dl);
#pragma unroll
    for (int r = 0; r < 16; ++r) negm[r] = -m_reg; }
#pragma unroll
  for (int r = 0; r < 16; ++r) p0[r] = __builtin_amdgcn_exp2f(p0[r]);
}
__device__ __forceinline__ void finishSM(f32x16& p0, f32x16& p1, bf16x8& pa0, bf16x8& pa1, bf16x8& pa2, bf16x8& pa3) {
#pragma unroll
  for (int r = 0; r < 16; ++r) p1[r] = __builtin_amdgcn_exp2f(p1[r]);
#define PK4(P, BASE, OUT) do { unsigned a0 = cvtpk_s(P[BASE + 0], P[BASE + 1]), a1 = cvtpk_s(P[BASE + 2], P[BASE + 3]);   \
    unsigned b0 = cvtpk_s(P[BASE + 4], P[BASE + 5]), b1 = cvtpk_s(P[BASE + 6], P[BASE + 7]);                              \
    auto r0 = __builtin_amdgcn_permlane32_swap(a0, b0, false, false); auto r1 = __builtin_amdgcn_permlane32_swap(a1, b1, false, false); \
    u32x4 w = {r0[0], r1[0], r0[1], r1[1]}; OUT = *reinterpret_cast<bf16x8*>(&w); } while (0)
  PK4(p0, 0, pa0); PK4(p0, 8, pa1); PK4(p1, 0, pa2); PK4(p1, 8, pa3);
#undef PK4
}
template <int DKB> __device__ __forceinline__ void qkt(f32x16& p0, f32x16& p1, const char* Ks, const bf16x8* qr, const f32x16& negm, int r32, int hi) {
#pragma unroll
  for (int d0 = 0; d0 < DKB; ++d0) { int cb = (d0 * 16 + hi * 8) * 2;
    bf16x8 b0 = *reinterpret_cast<const bf16x8*>(Ks + KSWZ(r32, cb));
    bf16x8 b1 = *reinterpret_cast<const bf16x8*>(Ks + KSWZ(32 + r32, cb));
    if (d0 == 0) { p0 = __builtin_amdgcn_mfma_f32_32x32x16_bf16(b0, qr[0], negm, 0, 0, 0); p1 = __builtin_amdgcn_mfma_f32_32x32x16_bf16(b1, qr[0], negm, 0, 0, 0); }
    else { p0 = __builtin_amdgcn_mfma_f32_32x32x16_bf16(b0, qr[d0], p0, 0, 0, 0); p1 = __builtin_amdgcn_mfma_f32_32x32x16_bf16(b1, qr[d0], p1, 0, 0, 0); } }
}
__device__ __forceinline__ int v_st(int k, int c) { const int kk = (k & ~0xC) | ((k & 4) << 1) | ((k & 8) >> 1); return ((kk >> 3) * 4 + (c >> 5)) * 512 + ((kk & 7) * 32 + (c & 31)) * 2; }
__device__ __forceinline__ int v_rd_base(int lane) { return ((lane & 3) << 3) | (((lane >> 2) & 3) << 6) | (((lane >> 4) & 1) << 5) | (((lane >> 5) & 1) << 8); }
constexpr int v_rd_off(int d0, int ks, int half) { return d0 * 512 + ks * 4096 + half * 2048; }
template <int OFF> __device__ __forceinline__ s16x4 tr_read(int vb) {
  s16x4 r; asm volatile("ds_read_b64_tr_b16 %0, %1 offset:%2" : "=&v"(r) : "v"(vb), "i"(OFF) : "memory"); return r;
}
template <int D0> __device__ __forceinline__ void pv_one(f32x16& od, int vb, bf16x8 pa0, bf16x8 pa1, bf16x8 pa2, bf16x8 pa3) {
  const s16x4 l0 = tr_read<v_rd_off(D0, 0, 0)>(vb), h0 = tr_read<v_rd_off(D0, 0, 1)>(vb), l1 = tr_read<v_rd_off(D0, 1, 0)>(vb), h1 = tr_read<v_rd_off(D0, 1, 1)>(vb);
  const s16x4 l2 = tr_read<v_rd_off(D0, 2, 0)>(vb), h2 = tr_read<v_rd_off(D0, 2, 1)>(vb), l3 = tr_read<v_rd_off(D0, 3, 0)>(vb), h3 = tr_read<v_rd_off(D0, 3, 1)>(vb);
  asm volatile("s_waitcnt lgkmcnt(0)" ::: "memory"); SBAR();
#define PK(L, H) (bf16x8){L[0], L[1], L[2], L[3], H[0], H[1], H[2], H[3]}
  od = __builtin_amdgcn_mfma_f32_32x32x16_bf16(pa0, PK(l0, h0), od, 0, 0, 0);
  od = __builtin_amdgcn_mfma_f32_32x32x16_bf16(pa1, PK(l1, h1), od, 0, 0, 0);
  od = __builtin_amdgcn_mfma_f32_32x32x16_bf16(pa2, PK(l2, h2), od, 0, 0, 0);
  od = __builtin_amdgcn_mfma_f32_32x32x16_bf16(pa3, PK(l3, h3), od, 0, 0, 0);
#undef PK
}
__device__ __forceinline__ void pv_d0(f32x16* o, int vb, bf16x8 pa0, bf16x8 pa1, bf16x8 pa2, bf16x8 pa3) {
  const bf16x8 ones = {16256, 16256, 16256, 16256, 16256, 16256, 16256, 16256};
  pv_one<0>(o[0], vb, pa0, pa1, pa2, pa3);
  o[2] = __builtin_amdgcn_mfma_f32_32x32x16_bf16(pa0, ones, o[2], 0, 0, 0); o[2] = __builtin_amdgcn_mfma_f32_32x32x16_bf16(pa1, ones, o[2], 0, 0, 0);
  pv_one<1>(o[1], vb, pa0, pa1, pa2, pa3);
  o[2] = __builtin_amdgcn_mfma_f32_32x32x16_bf16(pa2, ones, o[2], 0, 0, 0); o[2] = __builtin_amdgcn_mfma_f32_32x32x16_bf16(pa3, ones, o[2], 0, 0, 0);
}
template <int DKB>
__device__ __forceinline__ void attn_unit(const bf16_t* Qb, int ldq, const bf16_t* K1, int ldk1, const bf16_t* K2, int ldk2, const bf16_t* Vh, int ldv, bf16_t* Ob, int ldo, int seq, char* lds, int tq0, const f32x2* tab, int wave) {
  const int tid = fresh_tid(wave), wid = wave, lane = tid & 63, r32 = lane & 31, hi = lane >> 5;
  char* V_lds = lds; char* K_lds = lds + 3 * SHM_V;
  float* ws = (float*)(lds + 3 * SHM_V + 3 * SHM_K) + wid * 64; float* al_l = ws + 32;
  float m_reg = 0.f; f32x16 o[3] = {}; bf16x8 qr[DKB]; f32x16 negm = {};
  constexpr float QC = Sc<DKB>::SCALE * 1.4426950408889634f;
  const bf16_t* Qw = Qb + (long)(wid * QBLK + r32) * ldq + hi * 8;
#pragma unroll
  for (int d0 = 0; d0 < DKB; ++d0) { u32x4 w = *reinterpret_cast<const u32x4*>(Qw + d0 * 16);
    if (DKB == 6 && d0 >= 4) {
      const int tq = tq0 + wid * QBLK + r32; const f32x2* tb = tab + (d0 == 4 ? (tq >> 6) : (tq & 63)) * 8 + hi * 4;
#pragma unroll
      for (int e = 0; e < 4; ++e) { const f32x2 cs = tb[e]; const float x0 = __uint_as_float(w[e] << 16), x1 = __uint_as_float(w[e] & 0xffff0000u);
        w[e] = cvt_pk_bf16((x0 * cs.x - x1 * cs.y) * QC, (x0 * cs.y + x1 * cs.x) * QC); }
    } else {
#pragma unroll
      for (int e = 0; e < 4; ++e) w[e] = cvt_pk_bf16(__uint_as_float(w[e] << 16) * QC, __uint_as_float(w[e] & 0xffff0000u) * QC); }
    qr[d0] = *reinterpret_cast<bf16x8*>(&w); }
  const int sr = tid >> 3, sc = (tid & 7) * 8, vst0 = v_st(sr, sc), kst0 = KSWZ(sr, sc * 2);
  const int sr2 = (tid & 255) >> 2, sc2 = (tid & 3) * 8, kst2 = KSWZ(sr2, (64 + sc2) * 2);
  const int vb0 = (int)(uintptr_t)V_lds + v_rd_base(lane);
  struct { bf16x8 vs, ks, k2; } sr_[2];
#define SLOAD(i, k0) do { sr_[i].vs = *reinterpret_cast<const bf16x8*>(&Vh[(long)((k0) + sr) * ldv + sc]); sr_[i].ks = *reinterpret_cast<const bf16x8*>(&K1[(long)((k0) + sr) * ldk1 + sc]); \
    if (DKB == 6) sr_[i].k2 = *reinterpret_cast<const bf16x8*>(&K2[(long)((k0) + sr2) * ldk2 + sc2]); } while (0)
#define SWRITE(off, i) do { *(bf16x8*)(V_lds + (off) + vst0) = sr_[i].vs; *(bf16x8*)(K_lds + (off) + kst0) = sr_[i].ks; \
    if (DKB == 6) *(bf16x8*)(K_lds + (off) + kst2) = sr_[i].k2; } while (0)
#define SWAIT() do { if (DKB == 6) asm volatile("s_waitcnt vmcnt(3)" ::: "memory"); else asm volatile("s_waitcnt vmcnt(2)" ::: "memory"); } while (0)
#define RESC(a) do { if (__any((a) < 1.f)) { if (hi == 0) al_l[r32] = (a); asm volatile("s_waitcnt lgkmcnt(0)" ::: "memory"); \
    _Pragma("unroll") for (int d = 0; d < 3; ++d) _Pragma("unroll") for (int r = 0; r < 16; ++r) o[d][r] *= al_l[crow(r, hi)]; } } while (0)
#define ROT() do { o_prev = o_cur; o_cur = o_next; o_next = (o_next == 2 * SLOT) ? 0 : o_next + SLOT; } while (0)
  constexpr int SLOT = 16384;
  f32x16 pA0, pA1, pB0, pB1; float alA, alB; bf16x8 pa0, pa1, pa2, pa3; const int NT = seq / KVBLK;
  constexpr int SE = 0, SO = 1;
  int o_prev = 0, o_cur = 0, o_next = SLOT;
  SLOAD(SE, 0); asm volatile("s_waitcnt vmcnt(0)" ::: "memory"); SWRITE(0, SE); __syncthreads();
  qkt<DKB>(pA0, pA1, K_lds, qr, negm, r32, hi); partialSM<true>(pA0, pA1, m_reg, negm, alA);
  SLOAD(SO, KVBLK); if (2 < NT) SLOAD(SE, 2 * KVBLK);
  SWAIT(); SWRITE(SLOT, SO); __syncthreads();
  ROT();
  for (int j = 1; j + 1 < NT; j += 2) {
    SBAR(); qkt<DKB>(pB0, pB1, K_lds + o_cur, qr, negm, r32, hi);
    finishSM(pA0, pA1, pa0, pa1, pa2, pa3); SBAR();
    SLOAD(SO, (j + 2) * KVBLK); SBAR();
    pv_d0(o, vb0 + o_prev, pa0, pa1, pa2, pa3); partialSM<false>(pB0, pB1, m_reg, negm, alB);
    SWAIT(); SWRITE(o_next, SE);
    RESC(alB); __syncthreads(); ROT();
    SBAR(); qkt<DKB>(pA0, pA1, K_lds + o_cur, qr, negm, r32, hi);
    finishSM(pB0, pB1, pa0, pa1, pa2, pa3); SBAR();
    if (j + 3 < NT) SLOAD(SE, (j + 3) * KVBLK); SBAR();
    pv_d0(o, vb0 + o_prev, pa0, pa1, pa2, pa3); partialSM<false>(pA0, pA1, m_reg, negm, alA);
    SWAIT(); SWRITE(o_next, SO);
    RESC(alA); __syncthreads(); ROT();
  }
  SBAR(); qkt<DKB>(pB0, pB1, K_lds + o_cur, qr, negm, r32, hi);
  finishSM(pA0, pA1, pa0, pa1, pa2, pa3); SBAR();
  pv_d0(o, vb0 + o_prev, pa0, pa1, pa2, pa3); partialSM<false>(pB0, pB1, m_reg, negm, alB);
  RESC(alB);
  finishSM(pB0, pB1, pa0, pa1, pa2, pa3); SBAR();
  pv_d0(o, vb0 + o_cur, pa0, pa1, pa2, pa3);
  float rli[16];
#pragma unroll
  for (int r = 0; r < 16; ++r) rli[r] = __builtin_amdgcn_rcpf(o[2][r]);
  bf16_t* Ow = Ob + (long)(wid * QBLK) * ldo;
#pragma unroll
  for (int r = 0; r < 16; ++r) { int orow = crow(r, hi);
#pragma unroll
    for (int d0 = 0; d0 < 2; ++d0) Ow[(long)orow * ldo + d0 * 32 + r32] = (bf16_t)f2bf(o[d0][r] * rli[r]); }
  __syncthreads();
#undef SLOAD
#undef SWRITE
#undef SWAIT
#undef RESC
#undef ROT
}
#undef SBAR
}

struct Ctx { int wave, G, bid; };
#define CTX_GW(c) ((c).bid * 8 + (c).wave)
#define CTX_NGW(c) ((c).G * 8)
#define CTX_VCU(c) (((c).G % 8 == 0) ? ((c).bid % 8) * ((c).G / 8) + (c).bid / 8 : (c).bid)
#define LOCAL_TID const int tid = c.wave * 64 + fresh_lane(); const int lane = tid & 63; (void)lane;

__device__ __forceinline__ void tr_item(const float* W, int ldw, int Kd, int k0, int n0, bf16_t* WT, int drow0, LAS float* scr, int lane) {
#pragma unroll 8
    for (int i = 0; i < 32; ++i) { const int kk = 2 * i + (lane >> 5); scr[kk * 33 + (lane & 31)] = W[(size_t)(k0 + kk) * ldw + n0 + (lane & 31)]; }
    asm volatile("s_waitcnt lgkmcnt(0)" ::: "memory");
    const int c = lane & 7;
#pragma unroll
    for (int j = 0; j < 4; ++j) { const int n = (lane >> 3) + 8 * j; const LAS float* s = scr + (8 * c) * 33 + n;
        u32x4 o; o.x = pk2(s[0 * 33], s[1 * 33]); o.y = pk2(s[2 * 33], s[3 * 33]); o.z = pk2(s[4 * 33], s[5 * 33]); o.w = pk2(s[6 * 33], s[7 * 33]);
        *(u32x4*)(WT + (size_t)(drow0 + n) * Kd + k0 + 8 * c) = o; }
    asm volatile("s_waitcnt lgkmcnt(0)" ::: "memory");
}
struct LayerW { const float *gate1, *up1, *dn1, *win, *uq, *ukv, *br, *wout, *gate2, *up2, *dn2; };
__device__ __forceinline__ void convert_weights(const Ctx& c, const LayerW& w, bf16_t* WB, LAS unsigned char* lds) {
    LOCAL_TID
    LAS float* scr = (LAS float*)(lds + c.wave * 16384);
    constexpr int I_G = 16 * 88, I_D = 44 * 32, I_IN = 16 * 85, I_GT = 16 * 96, I_UQ = 4 * 24, I_UKV = 2 * 32, I_BR = 8 * 32, I_OUT = 16 * 32;
    constexpr int NITEMS = 4 * I_G + 2 * I_D + I_IN + I_GT + I_UQ + I_UKV + 3 * I_BR + I_OUT;
    for (int it = CTX_GW(c); it < NITEMS; it += CTX_NGW(c)) {
        int r = it;
#define FFN_GU(src, dst, upofs) { const int kb = r / 88, nb = r % 88, n0 = nb * 32; tr_item(src, DFF, DM, kb * 64, n0, dst, (n0 >> 7) * 256 + (upofs) + (n0 & 127), scr, lane); }
        if (r < I_G) { FFN_GU(w.gate1, WB + WO_GU1, 0); continue; } r -= I_G;
        if (r < I_G) { FFN_GU(w.up1, WB + WO_GU1, 128); continue; } r -= I_G;
        if (r < I_G) { FFN_GU(w.gate2, WB + WO_GU2, 0); continue; } r -= I_G;
        if (r < I_G) { FFN_GU(w.up2, WB + WO_GU2, 128); continue; } r -= I_G;
#undef FFN_GU
        if (r < I_D) { const int kb = r / 32, nb = r % 32; tr_item(w.dn1, DM, DFF, kb * 64, nb * 32, WB + WO_DN1, nb * 32, scr, lane); continue; } r -= I_D;
        if (r < I_D) { const int kb = r / 32, nb = r % 32; tr_item(w.dn2, DM, DFF, kb * 64, nb * 32, WB + WO_DN2, nb * 32, scr, lane); continue; } r -= I_D;
        if (r < I_IN) { const int kb = r / 85, nb = r % 85; tr_item(w.win, 5792, DM, kb * 64, nb * 32, WB + WO_IN, nb * 32, scr, lane); continue; } r -= I_IN;
        if (r < I_GT) { const int kb = r / 96, nb = r % 96; tr_item(w.win, 5792, DM, kb * 64, 2720 + nb * 32, WB + WO_GATE, nb * 32, scr, lane); continue; } r -= I_GT;
        if (r < I_UQ) { const int kb = r / 24, nb = r % 24; tr_item(w.uq, 768, 256, kb * 64, nb * 32, WB + WO_UQ, nb * 32, scr, lane); continue; } r -= I_UQ;
        if (r < I_UKV) { const int kb = r / 32, nb = r % 32; tr_item(w.ukv, 1024, 128, kb * 64, nb * 32, WB + WO_UKV, nb * 32, scr, lane); continue; } r -= I_UKV;
        if (r < 3 * I_BR) { const int bi = r / I_BR, q = r % I_BR, kb = q / 32, nb = q % 32; tr_item(w.br + (size_t)bi * 512 * 1024, DM, 512, kb * 64, nb * 32, WB + WO_BR + (size_t)bi * 1024 * 512, nb * 32, scr, lane); continue; } r -= 3 * I_BR;
        { const int kb = r / 32, nb = r % 32; tr_item(w.wout, DM, DM, kb * 64, nb * 32, WB + WO_OUT, nb * 32, scr, lane); }
    }
    { unsigned zz = 0u; asm volatile("" : "+v"(zz));
      for (int i = c.bid * 512 + tid; i < 96 * 1024 / 8; i += c.G * 512) ((u32x4*)(WB + WO_IN + (size_t)2720 * 1024))[i] = (u32x4){zz, zz, zz, zz}; }
}

template <int MODE>
__device__ __forceinline__ void norm_rows(const Ctx& c, const float* xp, const float* xs, float* xbuf, const float* g, bf16_t* XN) {
    LOCAL_TID
    const f32x4* g4 = (const f32x4*)g + lane;
    f32x4 gv[4];
#pragma unroll
    for (int j = 0; j < 4; ++j) gv[j] = g4[64 * j];
    constexpr int RB = 4;
    for (int m0 = CTX_GW(c); m0 < MT; m0 += RB * CTX_NGW(c)) {
        f32x4 v[RB][4];
#pragma unroll
        for (int q = 0; q < RB; ++q) { const int m = m0 + q * CTX_NGW(c); if (m < MT) {
            const float* src = (MODE == 1) ? (m < MP ? xp + (size_t)m * DM : xs + (size_t)(m - MP) * DM) : xbuf + (size_t)m * DM;
            const f32x4* xr = (const f32x4*)src + lane;
#pragma unroll
            for (int j = 0; j < 4; ++j) v[q][j] = xr[64 * j]; } }
#pragma unroll
        for (int q = 0; q < RB; ++q) { const int m = m0 + q * CTX_NGW(c); if (m < MT) {
            float s = 0.f;
#pragma unroll
            for (int j = 0; j < 4; ++j) s += (v[q][j].x * v[q][j].x + v[q][j].y * v[q][j].y) + (v[q][j].z * v[q][j].z + v[q][j].w * v[q][j].w);
            const float rstd = 1.0f / sqrtf(wave_sum(s, lane) * (1.f / DM) + EPS);
            if (MODE == 1) { f32x4* xo = (f32x4*)(xbuf + (size_t)m * DM) + lane;
#pragma unroll
                for (int j = 0; j < 4; ++j) xo[64 * j] = v[q][j]; }
            if (MODE == 2) { f32x4* xo = (f32x4*)(xbuf + (size_t)m * DM) + lane;
#pragma unroll
                for (int j = 0; j < 4; ++j) xo[64 * j] = v[q][j] * rstd * gv[j]; }
            else { u32x2* o8 = (u32x2*)(XN + (size_t)m * DM) + lane;
#pragma unroll
                for (int j = 0; j < 4; ++j) { const f32x4 y = v[q][j] * rstd * gv[j]; u32x2 w; w.x = pk2(y.x, y.y); w.y = pk2(y.z, y.w); o8[64 * j] = w; } } } }
    }
}

__device__ __forceinline__ void misc_tables(const Ctx& c, unsigned char* ws, const float* w1, const float* b1, const float* w2, const float* b2, const float* freq) {
    LOCAL_TID
    f32x2* T2 = (f32x2*)(ws + WS_T2); f32x2* tabA = (f32x2*)(ws + WS_TABA); f32x2* tabM = (f32x2*)(ws + WS_TABM);
    const int gt = c.bid * 512 + tid, NT = c.G * 512;
    for (int j = gt; j < 8192; j += NT) { const float a = (float)j * (1.0f / 8192.0f); T2[j] = (f32x2){cospif(a), -sinpif(a)}; }
    for (int i = gt; i < 128 * 16; i += NT) { const int pos = i >> 4, f = i & 15; const float inv = powf(10000.0f, -(float)f / 16.0f); const float a = (float)pos * inv; tabA[i] = (f32x2){cosf(a), sinf(a)}; }
    for (int i = gt; i < 128 * 8; i += NT) { const int pos = i >> 3, f = i & 7; const float inv = powf(10000.0f, -(float)f / 8.0f); const float a = (float)pos * inv; tabM[i] = (f32x2){cosf(a), sinf(a)}; }
    for (int r = CTX_GW(c); r < 2 * 12288; r += CTX_NGW(c)) {
        const int l = r / 12288, q = r % 12288; const int L = q < 8192 ? 8192 : 4096; const int t = q < 8192 ? q : q - 8192;
        float* H2 = (float*)(ws + WS_H2 + (size_t)l * 3 * MiB) + (q < 8192 ? 0 : 8192 * 64) + (size_t)t * 64;
        const float tl = (float)t / (float)(L - 1); const float wv = 6.283185307179586f * (float)t / (float)L;
        float z = 0.f;
        if (lane == 0) z = tl;
        else if (lane < 33) { const int k = (lane - 1) & 15; const float f = 1e-4f + (float)k * ((15.0f - 1e-4f) / 15.0f); z = lane < 17 ? cosf(f * wv) : -sinf(f * wv); }
        const float* W1 = w1 + l * 33 * 64; const float* W2 = w2 + l * 64 * 64; const float fr = freq[l * 64 + lane];
        float a = b1[l * 64 + lane];
#pragma unroll
        for (int i = 0; i < 33; ++i) a += bcast_l(z, i) * W1[i * 64 + lane];
        const float h1 = sinf(fr * a);
        float a2 = b2[l * 64 + lane];
#pragma unroll 8
        for (int k = 0; k < 64; ++k) a2 += bcast_l(h1, k) * W2[k * 64 + lane];
        H2[lane] = sinf(fr * a2);
    }
}

__device__ __forceinline__ void tok_local(const Ctx& c, bf16_t* ZC, const float* gq, const float* gk, const float* gmq, const float* gmkv, const f32x2* tabA, const f32x2* tabM) {
    LOCAL_TID
    constexpr int RB = 4;
    for (int m0 = CTX_GW(c); m0 < MT; m0 += RB * CTX_NGW(c)) {
        unsigned raw[RB][9];
#pragma unroll
        for (int q = 0; q < RB; ++q) { const int m = m0 + q * CTX_NGW(c); if (m < MT) { const unsigned* zr = (const unsigned*)(ZC + (size_t)m * ZCW);
#pragma unroll
            for (int it = 0; it < 5; ++it) raw[q][it] = zr[it * 64 + lane];
            raw[q][5] = zr[C_CQ / 2 + lane]; raw[q][6] = zr[C_CQ / 2 + 64 + lane]; raw[q][7] = zr[C_CKV / 2 + lane]; raw[q][8] = zr[C_KR / 2 + (lane & 15)]; } }
#pragma unroll
        for (int q = 0; q < RB; ++q) { const int m = m0 + q * CTX_NGW(c); if (m < MT) {
        unsigned* zr = (unsigned*)(ZC + (size_t)m * ZCW); const int t = m < MP ? (m & (LP - 1)) : (m & (LS - 1));
#pragma unroll
        for (int it = 0; it < 5; ++it) { const int pidx = it * 64 + lane, head = pidx >> 5, pi = pidx & 31;
            const unsigned rw = raw[q][it]; const float x0 = bf2f(rw & 0xffffu), x1 = bf2f(rw >> 16);
            float ss = x0 * x0 + x1 * x1;
#pragma unroll
            for (int o = 1; o < 32; o <<= 1) ss += shfl_xor_l(ss, o, lane);
            const float r = 1.0f / sqrtf(ss * (1.f / 64.f) + EPS); const float* g = head < 8 ? gq : gk;
            const float n0 = x0 * r * g[2 * pi], n1 = x1 * r * g[2 * pi + 1];
            const int pos = pi < 16 ? (t >> 6) : (t & 63); const f32x2 cs = tabA[pos * 16 + (pi & 15)];
            zr[pidx] = pk2(n0 * cs.x - n1 * cs.y, n0 * cs.y + n1 * cs.x); }
        { const unsigned r0 = raw[q][5], r1 = raw[q][6];
          const float a0 = bf2f(r0 & 0xffffu), a1 = bf2f(r0 >> 16), b0 = bf2f(r1 & 0xffffu), b1 = bf2f(r1 >> 16);
          const float r = 1.0f / sqrtf(wave_sum(a0 * a0 + a1 * a1 + b0 * b0 + b1 * b1, lane) * (1.f / 256.f) + EPS);
          zr[C_CQ / 2 + lane] = pk2(a0 * r * gmq[2 * lane], a1 * r * gmq[2 * lane + 1]); zr[C_CQ / 2 + 64 + lane] = pk2(b0 * r * gmq[128 + 2 * lane], b1 * r * gmq[128 + 2 * lane + 1]); }
        { const unsigned r0 = raw[q][7]; const float a0 = bf2f(r0 & 0xffffu), a1 = bf2f(r0 >> 16);
          const float r = 1.0f / sqrtf(wave_sum(a0 * a0 + a1 * a1, lane) * (1.f / 128.f) + EPS);
          zr[C_CKV / 2 + lane] = pk2(a0 * r * gmkv[2 * lane], a1 * r * gmkv[2 * lane + 1]); }
        if (lane < 16) { const unsigned r0 = raw[q][8]; const float x0 = bf2f(r0 & 0xffffu), x1 = bf2f(r0 >> 16);
          const int pos = lane < 8 ? (t >> 6) : (t & 63); const f32x2 cs = tabM[pos * 8 + (lane & 7)];
          zr[C_KR / 2 + lane] = pk2(x0 * cs.x - x1 * cs.y, x0 * cs.y + x1 * cs.x); }
        } }
    }
}

__device__ __forceinline__ void short_conv8(const bf16_t* ZC, int m, int t, int L, int col, const float* wsh, const float* bsh, int hc, float* out) {
    const u32x4 zc = *(const u32x4*)(ZC + (size_t)m * ZCW + col);
    u32x4 zm = {0u, 0u, 0u, 0u}, zp = {0u, 0u, 0u, 0u};
    if (t > 0) zm = *(const u32x4*)(ZC + (size_t)(m - 1) * ZCW + col);
    if (t < L - 1) zp = *(const u32x4*)(ZC + (size_t)(m + 1) * ZCW + col);
#pragma unroll
    for (int e = 0; e < 8; ++e) { const unsigned a = zm[e >> 1], b = zc[e >> 1], d = zp[e >> 1];
        const float xm = (e & 1) ? __uint_as_float(a & 0xffff0000u) : __uint_as_float(a << 16);
        const float xc = (e & 1) ? __uint_as_float(b & 0xffff0000u) : __uint_as_float(b << 16);
        const float xp = (e & 1) ? __uint_as_float(d & 0xffff0000u) : __uint_as_float(d << 16);
        out[e] = xm * wsh[hc + e] + xc * wsh[1536 + hc + e] + xp * wsh[3072 + hc + e] + bsh[hc + e]; }
}
__device__ __forceinline__ void hy_fwd_tiles(const Ctx& c, const bf16_t* ZC, bf16_t* ST, const float* wsh, const float* bsh, LAS unsigned char* lds) {
    LOCAL_TID
    LAS bf16_t* T = (LAS bf16_t*)lds;
    const int tt = tid >> 3, cgp = tid & 7;
    for (int tile = c.bid; tile < (MT / 256) * 8; tile += c.G) {
        const int c0 = (tile & 7) * 64, mb = (tile >> 3) * 256; const int L = mb < MP ? LP : LS; const int ch = c0 + cgp * 8;
#pragma unroll
        for (int q = 0; q < 4; ++q) { const int m0 = mb + q * 64, t0 = m0 & (L - 1); const int m = m0 + tt, t = t0 + tt;
            float a[8], b[8];
            short_conv8(ZC, m, t, L, C_HY + 512 + ch, wsh, bsh, 512 + ch, a);
            short_conv8(ZC, m, t, L, C_HY + 1024 + ch, wsh, bsh, 1024 + ch, b);
#pragma unroll
            for (int e = 0; e < 8; ++e) T[q * 4608 + (cgp * 8 + e) * 72 + tt] = (bf16_t)f2bf(a[e] * b[e]); }
        __syncthreads();
#pragma unroll
        for (int q = 0; q < 4; ++q) { const int m0 = mb + q * 64, t0 = m0 & (L - 1), rb = m0 - t0; const int cl = tid >> 3, tch = tid & 7;
            const u32x4 v = *(const LAS u32x4*)(T + q * 4608 + cl * 72 + tch * 8);
            *(u32x4*)(ST + (size_t)rb * 512 + (size_t)(c0 + cl) * L + t0 + tch * 8) = v; }
        __syncthreads();
    }
}
__device__ __forceinline__ void hy_bwd_tiles(const Ctx& c, bf16_t* ZC, const bf16_t* ST, const float* wsh, const float* bsh, LAS unsigned char* lds) {
    LOCAL_TID
    LAS bf16_t* T = (LAS bf16_t*)lds;
    const int tt = tid >> 3, cgp = tid & 7;
    for (int tile = c.bid; tile < (MT / 256) * 8; tile += c.G) {
        const int c0 = (tile & 7) * 64, mb = (tile >> 3) * 256; const int L = mb < MP ? LP : LS; const int ch = c0 + cgp * 8;
#pragma unroll
        for (int q = 0; q < 4; ++q) { const int m0 = mb + q * 64, t0 = m0 & (L - 1), rb = m0 - t0; const int cl = tid >> 3, tch = tid & 7;
            const u32x4 v = *(const u32x4*)(ST + (size_t)rb * 512 + (size_t)(c0 + cl) * L + t0 + tch * 8);
            *(LAS u32x4*)(T + q * 4608 + cl * 72 + tch * 8) = v; }
        __syncthreads();
#pragma unroll
        for (int q = 0; q < 4; ++q) { const int m0 = mb + q * 64, t0 = m0 & (L - 1); const int m = m0 + tt, t = t0 + tt;
            float a[8];
            short_conv8(ZC, m, t, L, C_HY + ch, wsh, bsh, ch, a);
            float r[8];
#pragma unroll
            for (int e = 0; e < 8; ++e) r[e] = a[e] * bf2f(T[q * 4608 + (cgp * 8 + e) * 72 + tt]);
            u32x4 w; w.x = pk2(r[0], r[1]); w.y = pk2(r[2], r[3]); w.z = pk2(r[4], r[5]); w.w = pk2(r[6], r[7]);
            *(u32x4*)(ZC + (size_t)m * ZCW + C_YB + ch) = w; }
        __syncthreads();
    }
}

__device__ __forceinline__ float fadd_(float a, float b) { float r; asm("v_add_f32_e32 %0, %1, %2" : "=v"(r) : "v"(a), "v"(b)); return r; }
__device__ __forceinline__ float fsub_(float a, float b) { float r; asm("v_sub_f32_e32 %0, %1, %2" : "=v"(r) : "v"(a), "v"(b)); return r; }
__device__ __forceinline__ float fmul_(float a, float b) { float r; asm("v_mul_f32_e32 %0, %1, %2" : "=v"(r) : "v"(a), "v"(b)); return r; }
__device__ __forceinline__ float ffma_(float a, float b, float c) { float r; asm("v_fma_f32 %0, %1, %2, %3" : "=v"(r) : "v"(a), "v"(b), "v"(c)); return r; }
__device__ __forceinline__ float fnma_(float a, float b, float c) { float r; asm("v_fma_f32 %0, -%1, %2, %3" : "=v"(r) : "v"(a), "v"(b), "v"(c)); return r; }
__device__ __forceinline__ f32x2 cadd(f32x2 a, f32x2 b) { return (f32x2){fadd_(a.x, b.x), fadd_(a.y, b.y)}; }
__device__ __forceinline__ f32x2 csub(f32x2 a, f32x2 b) { return (f32x2){fsub_(a.x, b.x), fsub_(a.y, b.y)}; }
__device__ __forceinline__ f32x2 cscale(f32x2 a, float s) { return (f32x2){fmul_(a.x, s), fmul_(a.y, s)}; }
__device__ __forceinline__ f32x2 cmul(f32x2 a, f32x2 b) { return (f32x2){fnma_(a.y, b.y, fmul_(a.x, b.x)), ffma_(a.y, b.x, fmul_(a.x, b.y))}; }
__device__ __forceinline__ f32x2 cmulc(f32x2 a, f32x2 b) { return (f32x2){ffma_(a.y, b.y, fmul_(a.x, b.x)), fnma_(a.x, b.y, fmul_(a.y, b.x))}; }
__device__ __forceinline__ int PADI(int i) { return i + (i >> 4); }
__device__ __forceinline__ constexpr float c16f(int m) { return m == 0 ? 1.f : m == 1 ? 0.92387953251128674f : m == 2 ? 0.70710678118654752f : m == 3 ? 0.38268343236508977f : m == 4 ? 0.f : m == 5 ? -0.38268343236508977f : m == 6 ? -0.70710678118654752f : -0.92387953251128674f; }
__device__ __forceinline__ constexpr float s16f(int m) { return m == 0 ? 0.f : m == 1 ? 0.38268343236508977f : m == 2 ? 0.70710678118654752f : m == 3 ? 0.92387953251128674f : m == 4 ? 1.f : m == 5 ? 0.92387953251128674f : m == 6 ? 0.70710678118654752f : 0.38268343236508977f; }
#define CW16(m) ((f32x2){(m) == 0 ? 1.f : (m) == 1 ? k1 : (m) == 2 ? k2 : (m) == 3 ? k3 : (m) == 4 ? 0.f : (m) == 5 ? -k3 : (m) == 6 ? -k2 : -k1, (m) == 0 ? 0.f : (m) == 1 ? -k3 : (m) == 2 ? -k2 : (m) == 3 ? -k1 : (m) == 4 ? -1.f : (m) == 5 ? -k1 : (m) == 6 ? -k2 : -k3})
template <int R, bool UNIT> __device__ __forceinline__ void dif_regs(f32x2* v, f32x2 wb) {
    float k1 = 0.92387953251128674f, k2 = 0.70710678118654752f, k3 = 0.38268343236508977f; asm volatile("" : "+v"(k1), "+v"(k2), "+v"(k3));
#pragma unroll
    for (int t = 0; t < R; ++t) { constexpr int dummy = 0; (void)dummy; const int half = 1 << (R - 1 - t);
#pragma unroll
        for (int k = 0; k < (1 << R); ++k) if (!(k & half)) { const int kk = k & (half - 1), m = kk * (8 / half);
            const f32x2 a = v[k], b = v[k + half]; v[k] = cadd(a, b); const f32x2 d = csub(a, b);
            if (UNIT) { v[k + half] = (m == 0) ? d : (m == 4) ? (f32x2){d.y, -d.x} : cmul(d, CW16(m)); }
            else { const f32x2 tw = (m == 0) ? wb : cmul(wb, CW16(m)); v[k + half] = cmul(d, tw); } }
        if (!UNIT) wb = cmul(wb, wb); }
}
template <int R, bool UNIT> __device__ __forceinline__ void dit_regs(f32x2* v, f32x2 wbig) {
    float k1 = 0.92387953251128674f, k2 = 0.70710678118654752f, k3 = 0.38268343236508977f; asm volatile("" : "+v"(k1), "+v"(k2), "+v"(k3));
    f32x2 wbs[R]; wbs[R - 1] = wbig;
#pragma unroll
    for (int t = R - 2; t >= 0; --t) wbs[t] = cmul(wbs[t + 1], wbs[t + 1]);
#pragma unroll
    for (int t = 0; t < R; ++t) { const int half = 1 << t;
#pragma unroll
        for (int k = 0; k < (1 << R); ++k) if (!(k & half)) { const int kk = k & (half - 1), m = kk * (8 / half);
            const f32x2 a = v[k]; f32x2 b = v[k + half];
            if (UNIT) { if (m == 4) b = (f32x2){-b.y, b.x}; else if (m != 0) b = cmulc(b, CW16(m)); }
            else { const f32x2 tw = (m == 0) ? wbs[t] : cmul(wbs[t], CW16(m)); b = cmulc(b, tw); }
            v[k] = cadd(a, b); v[k + half] = csub(a, b); } }
}
template <int R> __device__ __forceinline__ void dif_pass_rt(LAS f32x2* X, int sl, const f32x2 wb_in, int tid) {
    float wbx = wb_in.x, wby = wb_in.y; asm volatile("" : "+v"(wbx), "+v"(wby)); const f32x2 wb = {wbx, wby};
    const int r = tid & ((1 << sl) - 1), base = ((tid >> sl) << (sl + R)) + r;
    LAS f32x2* Xb = X + PADI(base); f32x2 v[1 << R];
#pragma unroll
    for (int k = 0; k < (1 << R); ++k) v[k] = Xb[(k << sl) + ((k << sl) >> 4)];
    dif_regs<R, false>(v, wb);
#pragma unroll
    for (int k = 0; k < (1 << R); ++k) Xb[(k << sl) + ((k << sl) >> 4)] = v[k];
}
template <int R> __device__ __forceinline__ void dit_pass_rt(LAS f32x2* X, int sl, const f32x2 wb_in, int tid) {
    float wbx = wb_in.x, wby = wb_in.y; asm volatile("" : "+v"(wbx), "+v"(wby)); const f32x2 wbig = {wbx, wby};
    const int r = tid & ((1 << sl) - 1), base = ((tid >> sl) << (sl + R)) + r;
    LAS f32x2* Xb = X + PADI(base); f32x2 v[1 << R];
#pragma unroll
    for (int k = 0; k < (1 << R); ++k) v[k] = Xb[(k << sl) + ((k << sl) >> 4)];
    dit_regs<R, false>(v, wbig);
#pragma unroll
    for (int k = 0; k < (1 << R); ++k) Xb[(k << sl) + ((k << sl) >> 4)] = v[k];
}
template <int NPT> __device__ __forceinline__ int pass_sl(int ps) { return NPT == 16 ? (ps == 0 ? 9 : ps == 1 ? 5 : 1) : (ps == 0 ? 9 : ps == 1 ? 6 : 3); }
template <int NPT> __device__ __forceinline__ void fwd2_to_lds(LAS f32x2* Xe, LAS f32x2* Xo, const f32x2* tw, int tid, f32x2* ve, f32x2* vo) {
    constexpr int R = NPT == 16 ? 4 : 3;
    asm volatile("" : "+v"(tid)); __syncthreads();
    { LAS f32x2* Pe = Xe + PADI(tid); LAS f32x2* Po = Xo + PADI(tid);
#pragma unroll
      for (int k = 0; k < NPT; ++k) { Pe[544 * k] = ve[k]; Po[544 * k] = vo[k]; } }
    __syncthreads();
#pragma nounroll
    for (int ps = 0; ps < 3; ++ps) { int sl = pass_sl<NPT>(ps); asm volatile("" : "+s"(sl));
        const f32x2 wb = tw[(tid & ((1 << sl) - 1)) << (14 - R - sl)];
        dif_pass_rt<R>(Xe, sl, wb, tid); dif_pass_rt<R>(Xo, sl, wb, tid); __syncthreads(); }
}
template <int NPT> __device__ __forceinline__ void mid_spectrum(const LAS f32x2* X, int tid, f32x2* K, float sc) {
    if (NPT == 16) {
#pragma unroll
        for (int u = 0; u < 8; ++u) { const LAS f32x2* Xb = X + PADI(2 * tid) + 1088 * u; const f32x2 a = Xb[0], b = Xb[1]; K[2 * u] = cscale(cadd(a, b), sc); K[2 * u + 1] = cscale(csub(a, b), sc); } }
    else { f32x2 w[8]; const LAS f32x2* Xb = X + PADI(8 * tid);
#pragma unroll
        for (int k = 0; k < 8; ++k) w[k] = Xb[k];
        dif_regs<3, true>(w, (f32x2){1.f, 0.f});
#pragma unroll
        for (int k = 0; k < 8; ++k) K[k] = cscale(w[k], sc); }
}
template <int NPT> __device__ __forceinline__ void mid_mul(LAS f32x2* X, int tid, const f32x2* K) {
    if (NPT == 16) {
#pragma unroll
        for (int u = 0; u < 8; ++u) { LAS f32x2* Xb = X + PADI(2 * tid) + 1088 * u; const f32x2 a = Xb[0], b = Xb[1];
            const f32x2 s = cmul(cadd(a, b), K[2 * u]), d = cmul(csub(a, b), K[2 * u + 1]); Xb[0] = cadd(s, d); Xb[1] = csub(s, d); } }
    else { f32x2 w[8]; LAS f32x2* Xb = X + PADI(8 * tid);
#pragma unroll
        for (int k = 0; k < 8; ++k) w[k] = Xb[k];
        dif_regs<3, true>(w, (f32x2){1.f, 0.f});
#pragma unroll
        for (int k = 0; k < 8; ++k) w[k] = cmul(w[k], K[k]);
        dit_regs<3, true>(w, (f32x2){1.f, 0.f});
#pragma unroll
        for (int k = 0; k < 8; ++k) Xb[k] = w[k]; }
}
template <int NPT> __device__ __forceinline__ void conv2(LAS f32x2* Xe, LAS f32x2* Xo, const f32x2* tw, int tid, f32x2* ve, f32x2* vo, const f32x2* KE, const f32x2* KO) {
    fwd2_to_lds<NPT>(Xe, Xo, tw, tid, ve, vo);
    mid_mul<NPT>(Xe, tid, KE); mid_mul<NPT>(Xo, tid, KO);
    __syncthreads();
    constexpr int R = NPT == 16 ? 4 : 3;
#pragma nounroll
    for (int ps = 2; ps >= 0; --ps) { int sl = pass_sl<NPT>(ps); asm volatile("" : "+s"(sl));
        const f32x2 wb = tw[(tid & ((1 << sl) - 1)) << (14 - R - sl)];
        dit_pass_rt<R>(Xe, sl, wb, tid); dit_pass_rt<R>(Xo, sl, wb, tid); __syncthreads(); }
    { const LAS f32x2* Pe = Xe + PADI(tid); const LAS f32x2* Po = Xo + PADI(tid);
#pragma unroll
      for (int k = 0; k < NPT; ++k) { ve[k] = Pe[544 * k]; vo[k] = Po[544 * k]; } }
}
template <int NPT>
__device__ __forceinline__ void hyena_unit(LAS unsigned char* lds, int ch, int rowbase, int nb, const float* H2, const float* w3, const float* bias, bf16_t* ST, const f32x2* T2, int tid_in) {
    constexpr int N = 512 * NPT; int tid = tid_in; asm volatile("" : "+v"(tid));
    LAS f32x2* Xe = (LAS f32x2*)lds; LAS f32x2* Xo = (LAS f32x2*)(lds + 69632); LAS float* wsm = (LAS float*)(lds + 139264);
    __syncthreads();
    if (tid < 128) wsm[tid] = w3[(tid & 63) * 1024 + (tid >> 6) * 512 + ch];
    __syncthreads();
    LAS float* FW = (LAS float*)Xe; LAS float* BW = FW + N;
    const float dmin = -3.0701134573253945f, dmax = -15.350567286626973f;
    const float delta = fabsf(dmin + (float)ch * ((dmax - dmin) / 511.0f));
    const float bs = bias[ch];
    {
      const int lane = tid & 63, wv = tid >> 6, qs = lane & 3, rr = lane >> 2;
      float wf[16], wb[16];
#pragma unroll
      for (int s4 = 0; s4 < 4; ++s4)
#pragma unroll
          for (int e = 0; e < 4; ++e) { wf[s4 * 4 + e] = wsm[4 * (qs + 4 * s4) + e]; wb[s4 * 4 + e] = wsm[64 + 4 * (qs + 4 * s4) + e]; }
      const float tsc = -delta / (float)(N - 1);
#pragma unroll 2
      for (int it = 0; it < N / 128; ++it) { const int t = wv * (N / 8) + it * 16 + rr; const f32x4* hp = (const f32x4*)(H2 + (size_t)t * 64) + qs; float af = 0.f, ab = 0.f;
#pragma unroll
          for (int s4 = 0; s4 < 4; ++s4) { const f32x4 h = hp[4 * s4];
              af = ffma_(h.x, wf[s4 * 4], af); af = ffma_(h.y, wf[s4 * 4 + 1], af); af = ffma_(h.z, wf[s4 * 4 + 2], af); af = ffma_(h.w, wf[s4 * 4 + 3], af);
              ab = ffma_(h.x, wb[s4 * 4], ab); ab = ffma_(h.y, wb[s4 * 4 + 1], ab); ab = ffma_(h.z, wb[s4 * 4 + 2], ab); ab = ffma_(h.w, wb[s4 * 4 + 3], ab); }
          af += shfl_xor_l(af, 1, lane); ab += shfl_xor_l(ab, 1, lane); af += shfl_xor_l(af, 2, lane); ab += shfl_xor_l(ab, 2, lane);
          if (qs == 0) { const float win = expf((float)t * tsc); FW[t] = af * win + (t == 0 ? bs : 0.f); BW[t] = ab * win; } } }
    __syncthreads();
    f32x2 KE[NPT], KO[NPT];
    const f32x2* tw = T2;
    const float sc = 1.0f / (2.0f * (float)N);
    { f32x2 ve[NPT], vo[NPT];
#pragma unroll
      for (int i = 0; i < NPT; ++i) { const int j = tid + 512 * i; const float fr = FW[j], br = (j == 0) ? 0.f : BW[N - j]; const f32x2 w = T2[j * (8192 / N)]; const float d = fr - br;
          ve[i] = (f32x2){fadd_(fr, br), 0.f}; vo[i] = cscale(w, d); }
      fwd2_to_lds<NPT>(Xe, Xo, tw, tid, ve, vo);
      mid_spectrum<NPT>(Xe, tid, KE, sc); mid_spectrum<NPT>(Xo, tid, KO, sc); }
    for (int p = 0; p < nb / 2; ++p) {
        bf16_t* s0 = ST + (size_t)(rowbase + 2 * p * N) * 512 + (size_t)ch * N; bf16_t* s1 = s0 + (size_t)N * 512;
        f32x2 ve[NPT], vo[NPT];
#pragma unroll
        for (int i = 0; i < NPT; ++i) { const int j = tid + 512 * i; ve[i] = (f32x2){bf2f(s0[j]), bf2f(s1[j])}; vo[i] = cmul(ve[i], T2[j * (8192 / N)]); }
        conv2<NPT>(Xe, Xo, tw, tid, ve, vo, KE, KO);
#pragma unroll
        for (int i = 0; i < NPT; ++i) { const int j = tid + 512 * i; const f32x2 y = cadd(ve[i], cmulc(vo[i], T2[j * (8192 / N)]));
            s0[j] = (bf16_t)f2bf(y.x); s1[j] = (bf16_t)f2bf(y.y); }
    }
    __syncthreads();
}

#define XB_TMO      128
#define XB_XCNT(j)  (256  + 64 * (j))
#define XB_XSUB(j)  (1280 + 64 * (j))
#define XB_XGEN(j)  (2304 + 64 * (j))
#define XB_TOP      3328
#define XB_TOPGEN   3392
#define XCD_BAR_WORDS 3456
#define XB_SPIN_CAP (1u << 18)

__device__ __forceinline__ unsigned xb_ld(unsigned* p)              { return __hip_atomic_load(p, __ATOMIC_RELAXED, __HIP_MEMORY_SCOPE_AGENT); }
__device__ __forceinline__ unsigned xb_add(unsigned* p, unsigned v) { return __hip_atomic_fetch_add(p, v, __ATOMIC_RELAXED, __HIP_MEMORY_SCOPE_AGENT); }
__device__ __forceinline__ unsigned xb_xcc_id() { return (unsigned)__builtin_amdgcn_s_getreg((3 << 11) | 20) & 0xFu; }
#define XB_SPIN(cond, bar) do { unsigned _sp = 0; while (cond) { __builtin_amdgcn_s_sleep(1); \
    if ((++_sp & 255u) == 0u) { if (xb_ld(&(bar)[XB_TMO])) break; if (_sp > XB_SPIN_CAP) { atomicAdd(&(bar)[XB_TMO], 1u); break; } } } } while (0)

struct XcdBarrier {
    unsigned* bar; unsigned x; int w;
    volatile LAS unsigned* st;
};

__device__ __forceinline__ XcdBarrier xcd_barrier_post(unsigned* bar, volatile LAS unsigned* st) {
    XcdBarrier b; b.bar = bar; b.x = xb_xcc_id(); b.st = st; b.w = __builtin_amdgcn_readfirstlane((int)threadIdx.x >> 6);
    if (threadIdx.x == 0) (void)xb_add(&bar[XB_XCNT(b.x)], 1u);
    return b;
}
__device__ __forceinline__ void xcd_barrier_complete(unsigned* bar, unsigned x, unsigned& nloc, unsigned& nx) {
    const unsigned G = gridDim.x * gridDim.y * gridDim.z;
    unsigned sum, cnt, mine, sp = 0u;
    for (;;) {
        sum = 0u; cnt = 0u; mine = 0u;
#pragma unroll
        for (unsigned j = 0; j < 16; ++j) { const unsigned c = xb_ld(&bar[XB_XCNT(j)]); sum += c; cnt += (c > 0u) ? 1u : 0u; mine = (j == x) ? c : mine; }
        if (sum == G) break;
        __builtin_amdgcn_s_sleep(1);
        if ((++sp & 255u) == 0u) { if (xb_ld(&bar[XB_TMO])) break; if (sp > XB_SPIN_CAP) { atomicAdd(&bar[XB_TMO], 1u); break; } }
    }
    nloc = mine > 0u ? mine : 1u; nx = cnt > 0u ? cnt : 1u;
}

__device__ __forceinline__ void xcd_barrier_census(const XcdBarrier& b) {
    if (b.w == 0 && fresh_lane() == 0) { unsigned nloc, nx; xcd_barrier_complete(b.bar, b.x, nloc, nx); b.st[0] = nloc; b.st[1] = nx; }
    __syncthreads();
}
__device__ __forceinline__ void xcd_barrier(const XcdBarrier& b) {
    asm volatile("s_waitcnt vmcnt(0)" ::: "memory");
    __syncthreads();
    if (b.w == 0 && fresh_lane() == 0) {
        unsigned* bar = b.bar;
        __builtin_amdgcn_s_waitcnt(0);
        unsigned nloc = b.st[0], nx = b.st[1];
        const unsigned old = xb_add(&bar[XB_XSUB(b.x)], 1u);
        const unsigned gen = old / nloc;
        if (old + 1u == (gen + 1u) * nloc) {
            __builtin_amdgcn_fence(__ATOMIC_RELEASE, "agent");
            asm volatile("s_waitcnt vmcnt(0)" ::: "memory");
            const unsigned og = xb_add(&bar[XB_TOP], 1u);
            const unsigned tg = og / nx;
            if (og + 1u == (tg + 1u) * nx) xb_add(&bar[XB_TOPGEN], 1u);
            else XB_SPIN(xb_ld(&bar[XB_TOPGEN]) == tg, bar);
            __builtin_amdgcn_fence(__ATOMIC_ACQUIRE, "agent");
            xb_add(&bar[XB_XGEN(b.x)], 1u);
            asm volatile("s_waitcnt vmcnt(0)" ::: "memory");
        } else {
            XB_SPIN(xb_ld(&bar[XB_XGEN(b.x)]) == gen, bar);
            __builtin_amdgcn_fence(__ATOMIC_ACQUIRE, "agent");
            asm volatile("s_waitcnt vmcnt(0)" ::: "memory");
        }
    }
    __syncthreads();
}


#ifndef PROBE_SKIP
#define PROBE_SKIP 0
#endif
constexpr int NPASS = PROBE_SKIP ? 2 : 1;
#define DO(bit) (pass == NPASS - 1 || !(PROBE_SKIP & (bit)))
struct Params { const float* in[30]; float* out; unsigned char* ws; };

__global__ void __launch_bounds__(512, 2) mk_fwd(Params p) {
    extern __shared__ __attribute__((aligned(16))) unsigned char lds_raw[];
    cg::grid_group grid = cg::this_grid();
    LAS unsigned char* lds = (LAS unsigned char*)lds_raw;
    Ctx c; c.wave = __builtin_amdgcn_readfirstlane((int)threadIdx.x >> 6); c.G = gridDim.x; c.bid = blockIdx.x;
    unsigned char* ws = p.ws; float* x = p.out;
    { volatile LAS unsigned* st = (volatile LAS unsigned*)(lds + LDS_BYTES - 16); if (threadIdx.x < 4) st[threadIdx.x] = 0u; }
    __syncthreads();
    const XcdBarrier xbar = xcd_barrier_post((unsigned*)(p.ws + WS_BAR), (volatile LAS unsigned*)(lds + LDS_BYTES - 16));
#define WB ((bf16_t*)(ws + WS_W))
#define XN ((bf16_t*)(ws + WS_XN))
#define BIG ((bf16_t*)(ws + WS_BIG))
#define ST ((bf16_t*)(ws + WS_ST))
#define QH ((bf16_t*)(ws + WS_QH))
#define KVH ((bf16_t*)(ws + WS_KVH))
#define MG ((bf16_t*)(ws + WS_MG))
#define PB ((bf16_t*)(ws + WS_PB))
#define T2 ((const f32x2*)(ws + WS_T2))
#define tabA ((const f32x2*)(ws + WS_TABA))
#define tabM ((const f32x2*)(ws + WS_TABM))
#define SSQ(i) ((float*)(ws + WS_W + WO_END * 2) + (size_t)(i) * MT)
#define LAUNDER() asm volatile("" : "+s"(c.bid), "+s"(c.G), "+s"(ws), "+s"(x))
#define SYNC() do { xcd_barrier(xbar); LAUNDER(); } while (0)
#define SYNC_CG() do { grid.sync(); LAUNDER(); } while (0)
    for (int pass = 0; pass < NPASS; ++pass) {
    misc_tables(c, ws, p.in[12], p.in[13], p.in[14], p.in[15], p.in[17]);

#define GEMMX(BIT, EPI, Aptr, LDA, Bptr, NN, KK, ...) do { if (!DO(BIT)) break; pg8::Gemm g_{(const bf16_t*)(Aptr), (const bf16_t*)(Bptr), MT, NN, KK, LDA}; pg8::StaticOrder S_; S_.init(MT, NN, c.G, c.bid); \
        EPI E_{__VA_ARGS__}; pg8::gemm_phase<EPI>(lds, g_, S_, E_, c.wave); } while (0)
#define GEMM(...) GEMMX(2, __VA_ARGS__)
#define GEMMF(...) GEMMX(16, __VA_ARGS__)

    for (int l = 0; l < 2; ++l) {
        LAUNDER();
        { LayerW w; w.gate1 = p.in[3] + (size_t)l * DM * DFF; w.up1 = p.in[4] + (size_t)l * DM * DFF; w.dn1 = p.in[5] + (size_t)l * DFF * DM; w.win = p.in[7] + (size_t)l * DM * 5792;
          w.uq = p.in[20] + (size_t)l * 256 * 768; w.ukv = p.in[22] + (size_t)l * 128 * 1024; w.br = p.in[23] + (size_t)l * 3 * 512 * 1024; w.wout = p.in[24] + (size_t)l * DM * DM;
          w.gate2 = p.in[26] + (size_t)l * DM * DFF; w.up2 = p.in[27] + (size_t)l * DM * DFF; w.dn2 = p.in[28] + (size_t)l * DFF * DM;
          if (DO(8)) convert_weights(c, w, WB, lds); }
        if (l == 0 && DO(8)) norm_rows<1>(c, p.in[0], p.in[1], x, p.in[2], XN);
        if (l == 0) { SYNC_CG(); xcd_barrier_census(xbar); } else SYNC();
        const float* ssA = l == 0 ? nullptr : SSQ(0);
        float* ssMix = SSQ(0); float* ssF2 = SSQ(0);
        GEMMF(pg8::EpiSwiglu, XN, DM, WB + WO_GU1, 5632, DM, BIG, DFF, ssA);
        SYNC();
        GEMMF(pg8::EpiResid<1>, BIG, DFF, WB + WO_DN1, DM, DFF, x, p.in[6] + l * DM, XN, ssMix, (LAS float*)(lds + 131072));
        SYNC();
        GEMM(pg8::EpiStore, XN, DM, WB + WO_IN, ZCW, DM, BIG, ZCW, ssMix);
        SYNC();
        if (DO(8)) tok_local(c, BIG, p.in[8] + l * 64, p.in[9] + l * 64, p.in[19] + l * 256, p.in[21] + l * 128, tabA, tabM);
        if (DO(8)) hy_fwd_tiles(c, BIG, ST, p.in[10] + (size_t)l * 3 * 1536, p.in[11] + l * 1536, lds);
        SYNC();
        GEMM(pg8::EpiStore, BIG + C_CQ, ZCW, WB + WO_UQ, 768, 256, QH, 768, nullptr);
        GEMM(pg8::EpiStore, BIG + C_CKV, ZCW, WB + WO_UKV, 1024, 128, KVH, 1024, nullptr);
        __syncthreads();
        { const float* H2l = (const float*)(ws + WS_H2 + (size_t)l * 3 * MiB); const float* w3 = p.in[16] + (size_t)l * 64 * 1024; const float* hb = p.in[18] + l * 512;
          if (DO(4)) for (int u = c.bid; u < 1024; u += c.G) {
              if (u < 512) hyena_unit<16>(lds, u, 0, 8, H2l, w3, hb, ST, T2, c.wave * 64 + fresh_lane());
              else hyena_unit<8>(lds, u - 512, MP, 4, H2l + 8192 * 64, w3, hb, ST, T2, c.wave * 64 + fresh_lane()); } }
        __syncthreads();
        if (DO(1)) for (int i = 0;; ++i) { const int u = i * c.G + CTX_VCU(c); if (u >= 2560) break;
            int rowbase, qb, h, L;
            if (u < 2048) { qb = u & 31; h = (u >> 5) & 7; rowbase = (u >> 8) * LP; L = LP; } else { const int v = u - 2048; qb = v & 15; h = (v >> 4) & 7; rowbase = MP + (v >> 7) * LS; L = LS; }
            bf16_t* Qb = BIG + (size_t)(rowbase + qb * 256) * ZCW + C_Q + h * 64; const bf16_t* Kb = BIG + (size_t)rowbase * ZCW + C_K + (h >> 2) * 64; const bf16_t* Vb = BIG + (size_t)rowbase * ZCW + C_V + (h >> 2) * 64;
            att::attn_unit<4>(Qb, ZCW, Kb, ZCW, nullptr, 0, Vb, ZCW, Qb, ZCW, L, (char*)lds_raw, 0, nullptr, c.wave); }
        SYNC();
        if (DO(1)) for (int i = 0;; ++i) { const int u = i * c.G + CTX_VCU(c); if (u >= 2560) break;
            int rowbase, qb, h, L;
            if (u < 2048) { qb = u & 31; h = (u >> 5) & 7; rowbase = (u >> 8) * LP; L = LP; } else { const int v = u - 2048; qb = v & 15; h = (v >> 4) & 7; rowbase = MP + (v >> 7) * LS; L = LS; }
            const bf16_t* Qb = QH + (size_t)(rowbase + qb * 256) * 768 + h * 96; const bf16_t* K1 = KVH + (size_t)rowbase * 1024 + h * 128; const bf16_t* K2 = BIG + (size_t)rowbase * ZCW + C_KR;
            const bf16_t* Vb = K1 + 64; bf16_t* Ob = BIG + (size_t)(rowbase + qb * 256) * ZCW + C_YC + h * 64;
            att::attn_unit<6>(Qb, 768, K1, 1024, K2, ZCW, Vb, 1024, Ob, ZCW, L, (char*)lds_raw, qb * 256, tabM, c.wave); }
        if (DO(8)) hy_bwd_tiles(c, BIG, ST, p.in[10] + (size_t)l * 3 * 1536, p.in[11] + l * 1536, lds);
        SYNC();
        GEMM(pg8::EpiStore, BIG + C_Q, ZCW, WB + WO_BR, DM, 512, MG, DM, nullptr);
        GEMM(pg8::EpiGate<0>, XN, DM, WB + WO_GATE, DM, DM, MG, MG, ssMix);
        GEMM(pg8::EpiStore, BIG + C_YB, ZCW, WB + WO_BR + (size_t)1024 * 512, DM, 512, PB, DM, nullptr);
        GEMM(pg8::EpiGate<1>, XN, DM, WB + WO_GATE + (size_t)1024 * 1024, DM, DM, MG, PB, ssMix);
        GEMM(pg8::EpiStore, BIG + C_YC, ZCW, WB + WO_BR + (size_t)2 * 1024 * 512, DM, 512, PB, DM, nullptr);
        GEMM(pg8::EpiGate<1>, XN, DM, WB + WO_GATE + (size_t)2 * 1024 * 1024, DM, DM, MG, PB, ssMix);
        SYNC();
        GEMM(pg8::EpiResid<0>, MG, DM, WB + WO_OUT, DM, DM, x, p.in[25] + l * DM, XN, ssF2, (LAS float*)(lds + 131072));
        SYNC();
        GEMMF(pg8::EpiSwiglu, XN, DM, WB + WO_GU2, 5632, DM, BIG, DFF, ssF2);
        SYNC();
        GEMMF(pg8::EpiResid<1>, BIG, DFF, WB + WO_DN2, DM, DFF, x, l == 0 ? p.in[2] + DM : nullptr, XN, SSQ(0), (LAS float*)(lds + 131072));
        SYNC();
    }
    norm_rows<2>(c, nullptr, nullptr, x, p.in[29], nullptr);
    if (pass + 1 < NPASS) SYNC();
    }
}

extern "C" void kernel_launch(void* const* d_in, const int* in_sizes, int n_in, void* d_out, int out_size, void* d_ws, size_t ws_size, hipStream_t stream) {
    static int grid = 0;
    if (grid == 0) {
        if (n_in != 30 || out_size != MT * DM || ws_size < WS_END) { fprintf(stderr, "kernel_launch: unexpected shapes: n_in %d out %d ws %zu\n", n_in, out_size, ws_size); grid = -1; return; }
        int dev = 0, cus = 0, per_cu = 0;
        hipGetDevice(&dev); hipDeviceGetAttribute(&cus, hipDeviceAttributeMultiprocessorCount, dev);
        if (hipFuncSetAttribute((const void*)mk_fwd, hipFuncAttributeMaxDynamicSharedMemorySize, LDS_BYTES) != hipSuccess) { fprintf(stderr, "kernel_launch: hipFuncSetAttribute failed\n"); grid = -1; return; }
        hipOccupancyMaxActiveBlocksPerMultiprocessor(&per_cu, (const void*)mk_fwd, 512, LDS_BYTES);
        if (per_cu < 1) { fprintf(stderr, "kernel_launch: occupancy query says %d\n", per_cu); per_cu = 1; }
        (void)hipGetLastError();
        grid = cus * 1;
    }
    if (grid < 0) return;
    if (hipMemsetAsync((char*)d_ws + WS_BAR, 0, 16384, stream) != hipSuccess) { fprintf(stderr, "kernel_launch: memset failed\n"); return; }
    Params p{};
    for (int i = 0; i < 30; ++i) p.in[i] = (const float*)d_in[i];
    p.out = (float*)d_out; p.ws = (unsigned char*)d_ws;
    void* args[] = {&p};
    hipError_t e = hipLaunchCooperativeKernel((const void*)mk_fwd, dim3(grid), dim3(512), args, LDS_BYTES, stream);
    if (e != hipSuccess) fprintf(stderr, "cooperative launch failed: %s (grid %d)\n", hipGetErrorString(e), grid);
}
```

```cpp
#include <hip/hip_runtime.h>
#include <hip/hip_bf16.h>
#include <hip/hip_cooperative_groups.h>
#include <cstdio>
#include <cstdint>
namespace cg = cooperative_groups;

#define LAS __attribute__((address_space(3)))
typedef unsigned short bf16_t;
typedef short bf16x8 __attribute__((ext_vector_type(8)));
typedef short s16x4 __attribute__((ext_vector_type(4)));
typedef float f32x4 __attribute__((ext_vector_type(4)));
typedef float f32x2 __attribute__((ext_vector_type(2)));
typedef float f32x16 __attribute__((ext_vector_type(16)));
typedef unsigned u32x4 __attribute__((ext_vector_type(4)));
typedef unsigned u32x2 __attribute__((ext_vector_type(2)));

constexpr int DM = 1024, DFF = 2816, MP = 65536, MS = 16384, MT = MP + MS;
constexpr int LP = 8192, LS = 4096;
constexpr int ZCW = 2816;
constexpr int C_Q = 0, C_K = 512, C_V = 640, C_HY = 768, C_CQ = 2304, C_CKV = 2560, C_KR = 2688;
constexpr int C_YB = 1280, C_YC = 1792;
constexpr float EPS = 1e-6f;
constexpr size_t MiB = 1u << 20;
constexpr size_t WS_T2 = 0, WS_TABA = 64 * 1024, WS_TABM = 80 * 1024, WS_H2 = 1 * MiB;
constexpr size_t WS_BAR = 7 * MiB;
constexpr size_t WS_W = 8 * MiB;
constexpr size_t WS_XN = 60 * MiB;
constexpr size_t WS_BIG = 220 * MiB;
constexpr size_t WS_R2 = 660 * MiB;
constexpr size_t WS_ST = WS_R2;
constexpr size_t WS_QH = WS_R2 + 80 * MiB;
constexpr size_t WS_KVH = WS_R2 + 200 * MiB;
constexpr size_t WS_MG = WS_R2;
constexpr size_t WS_PB = WS_R2 + 160 * MiB;
constexpr size_t WS_END = 1024 * MiB;
constexpr size_t WO_GU1 = 0, WO_DN1 = WO_GU1 + 5632 * 1024, WO_IN = WO_DN1 + 1024 * 2816, WO_GATE = WO_IN + 2816 * 1024, WO_UQ = WO_GATE + 3072 * 1024,
                 WO_UKV = WO_UQ + 768 * 256, WO_BR = WO_UKV + 1024 * 128, WO_OUT = WO_BR + 3 * 1024 * 512, WO_GU2 = WO_OUT + 1024 * 1024, WO_DN2 = WO_GU2 + 5632 * 1024,
                 WO_END = WO_DN2 + 1024 * 2816;
static_assert(WO_END * 2 + 5 * (size_t)MT * 4 <= 52 * MiB, "weights + row statistics fit");
constexpr int LDS_BYTES = 139264 + 2048;

__device__ __forceinline__ int fresh_lane() { int l; asm volatile("v_mbcnt_lo_u32_b32 %0, -1, 0\n\tv_mbcnt_hi_u32_b32 %0, -1, %0" : "=v"(l)); return l; }
__device__ __forceinline__ int fresh_tid(int wave) { return wave * 64 + fresh_lane(); }
__device__ __forceinline__ float bf2f(unsigned h) { return __uint_as_float(h << 16); }
__device__ __forceinline__ unsigned f2bf(float f) { unsigned u = __float_as_uint(f); return (u + 0x7fffu + ((u >> 16) & 1u)) >> 16; }
__device__ __forceinline__ unsigned pk2(float lo, float hi) { return f2bf(lo) | (f2bf(hi) << 16); }
typedef __bf16 bf16x2_t_ __attribute__((ext_vector_type(2)));
__device__ __forceinline__ unsigned cvt_pk_bf16(float lo, float hi) { f32x2 v = {lo, hi}; bf16x2_t_ b = __builtin_convertvector(v, bf16x2_t_); return __builtin_bit_cast(unsigned, b); }
__device__ __forceinline__ float shfl_xor_l(float v, int o, int lane) { return __int_as_float(__builtin_amdgcn_ds_bpermute((lane ^ o) << 2, __float_as_int(v))); }
__device__ __forceinline__ float bcast_l(float v, int src) { return __int_as_float(__builtin_amdgcn_readlane(__float_as_int(v), src)); }
__device__ __forceinline__ float wave_sum(float v, int lane) {
#pragma unroll
    for (int o = 1; o < 64; o <<= 1) v += shfl_xor_l(v, o, lane);
    return v;
}
__device__ __forceinline__ float sigmoidf_(float x) { return __builtin_amdgcn_rcpf(1.0f + __builtin_amdgcn_exp2f(-1.4426950408889634f * x)); }

namespace pg8 {
constexpr int BM = 256, BK = 64, HALF = 128, HTB = HALF * BK * 2, STAGE_BYTES = 8 * HTB, NXCD = 8, WGM = 8;
__host__ __device__ __forceinline__ int lds_byte(int r, int c) { const int st = (r >> 4) * 2 + (c >> 5), rr = r & 15, cc = c & 31, ob = rr * 64 + cc * 2; return st * 1024 + (ob ^ (((ob >> 9) & 1) << 5)); }
__host__ __device__ __forceinline__ void stage_rc(int b, int& R, int& C) { const int st = b / 1024, sb = b % 1024, swz = sb ^ (((sb >> 9) & 1) << 5); R = (st >> 1) * 16 + swz / 64; C = (st & 1) * 32 + (swz % 64) / 2; }
__host__ __device__ __forceinline__ int perm32(int rho) { const int n = rho >> 4, i = rho & 15; return 8 * (i >> 2) + 4 * n + (i & 3); }
struct Unit { int pm, pn; };
struct Gemm { const bf16_t* A; const bf16_t* Bt; int M, N, K, lda; };
struct StaticOrder {
    int nM, nN, nwg, G, c;
    __device__ void init(int M, int N, int G_, int c_) { nM = M / BM; nN = N / BM; nwg = nM * nN; G = G_; c = c_; }
    __device__ bool next(int i, Unit& u) const {
        const long L = (long)i * G + c; if (L >= nwg) return false;
        int wgid = (int)L; { const int q = nwg / NXCD, r = nwg % NXCD, xcd = wgid % NXCD, off = wgid / NXCD; wgid = (xcd < r ? xcd * (q + 1) : r * (q + 1) + (xcd - r) * q) + off; }
        const int nig = WGM * nN, gid = wgid / nig, fm = gid * WGM, gsz = (nM - fm) < WGM ? (nM - fm) : WGM;
        u.pm = fm + ((wgid % nig) % gsz); u.pn = (wgid % nig) / gsz; return true;
    }
};
typedef f32x4 Acc[2][2][4][2];

struct EpiStore {
    bf16_t* O; int ldc; const float* ss;
    __device__ __forceinline__ void operator()(const Acc& acc, const Unit& u, int wr, int wc, int fr, int fq) const {
        const int row0 = u.pm * BM + wr * 64 + fr, col0 = u.pn * BM + wc * 32 + 8 * fq;
#pragma unroll
        for (int ai = 0; ai < 2; ++ai)
#pragma unroll
            for (int m = 0; m < 4; ++m) { const int row = row0 + ai * HALF + m * 16; bf16_t* rowp = O + (size_t)row * ldc + col0;
                const float rs = ss ? __builtin_amdgcn_rsqf(((ss[row] + ss[MT + row]) + (ss[2 * MT + row] + ss[3 * MT + row])) * (1.f / DM) + EPS) : 1.f;
#pragma unroll
                for (int bj = 0; bj < 2; ++bj) { const f32x4 v0 = acc[ai][bj][m][0] * rs, v1 = acc[ai][bj][m][1] * rs;
                    u32x4 w; w.x = cvt_pk_bf16(v0[0], v0[1]); w.y = cvt_pk_bf16(v0[2], v0[3]); w.z = cvt_pk_bf16(v1[0], v1[1]); w.w = cvt_pk_bf16(v1[2], v1[3]);
                    *(u32x4*)(rowp + bj * HALF) = w; } }
    }
};
struct EpiSwiglu {
    bf16_t* O; int ldc; const float* ss;
    __device__ __forceinline__ void operator()(const Acc& acc, const Unit& u, int wr, int wc, int fr, int fq) const {
        const int row0 = u.pm * BM + wr * 64 + fr, col0 = u.pn * HALF + wc * 32 + 8 * fq;
#pragma unroll
        for (int ai = 0; ai < 2; ++ai)
#pragma unroll
            for (int m = 0; m < 4; ++m) { const int row = row0 + ai * HALF + m * 16; bf16_t* rowp = O + (size_t)row * ldc + col0;
                const float rs = ss ? __builtin_amdgcn_rsqf(((ss[row] + ss[MT + row]) + (ss[2 * MT + row] + ss[3 * MT + row])) * (1.f / DM) + EPS) : 1.f;
                float h[8];
#pragma unroll
                for (int n = 0; n < 2; ++n)
#pragma unroll
                    for (int j = 0; j < 4; ++j) { const float g = acc[ai][0][m][n][j] * rs, up = acc[ai][1][m][n][j] * rs; h[n * 4 + j] = g * sigmoidf_(g) * up; }
                u32x4 w; w.x = cvt_pk_bf16(h[0], h[1]); w.y = cvt_pk_bf16(h[2], h[3]); w.z = cvt_pk_bf16(h[4], h[5]); w.w = cvt_pk_bf16(h[6], h[7]);
                *(u32x4*)rowp = w; }
    }
};
template <int HALFA> struct EpiResid {
    float* X_; const float* gnext_; bf16_t* XNo_; float* ss_; LAS float* part_; const float* Rp_; const float* Rs_;
    __device__ __forceinline__ void operator()(const Acc& acc, const Unit& u, int wr, int wc, int fr, int fq) const {
        float* const X = X_; const float alpha = HALFA ? 0.5f : 1.0f; const float* const gnext = gnext_; bf16_t* const XNo = XNo_; float* const ss = ss_; LAS float* const part = part_;
        const float* const R = Rp_ ? (u.pm * BM < MP ? Rp_ : Rs_ - (size_t)MP * DM) : X;
        const int row0 = u.pm * BM + wr * 64 + fr, col0 = u.pn * BM + wc * 32 + 8 * fq; const int lane = fr + 16 * fq;
        f32x4 gv[2][2];
        if (gnext) {
#pragma unroll
            for (int bj = 0; bj < 2; ++bj)
#pragma unroll
                for (int n = 0; n < 2; ++n) gv[bj][n] = *(const f32x4*)(gnext + col0 + bj * HALF + 4 * n); }
#pragma unroll
        for (int ai = 0; ai < 2; ++ai)
#pragma unroll
            for (int m = 0; m < 4; ++m) { const int row = row0 + ai * HALF + m * 16; float* rowp = X + (size_t)row * DM + col0; float sq = 0.f;
#pragma unroll
                for (int bj = 0; bj < 2; ++bj) { f32x4* p0 = (f32x4*)(rowp + bj * HALF); const f32x4* r0 = (const f32x4*)(R + (size_t)row * DM + col0 + bj * HALF); const f32x4 o0 = r0[0] + acc[ai][bj][m][0] * alpha, o1 = r0[1] + acc[ai][bj][m][1] * alpha; p0[0] = o0; p0[1] = o1;
                    if (gnext) { sq += (o0[0] * o0[0] + o0[1] * o0[1]) + (o0[2] * o0[2] + o0[3] * o0[3]) + (o1[0] * o1[0] + o1[1] * o1[1]) + (o1[2] * o1[2] + o1[3] * o1[3]);
                        const f32x4 y0 = o0 * gv[bj][0], y1 = o1 * gv[bj][1];
                        u32x4 w; w.x = cvt_pk_bf16(y0[0], y0[1]); w.y = cvt_pk_bf16(y0[2], y0[3]); w.z = cvt_pk_bf16(y1[0], y1[1]); w.w = cvt_pk_bf16(y1[2], y1[3]);
                        *(u32x4*)(XNo + (size_t)row * DM + col0 + bj * HALF) = w; } }
                if (gnext) { sq += shfl_xor_l(sq, 16, lane); sq += shfl_xor_l(sq, 32, lane); if (fq == 0) part[wc * 256 + ai * HALF + wr * 64 + m * 16 + fr] = sq; }
                asm volatile("" ::: "memory"); }
        if (gnext) {
            asm volatile("s_waitcnt lgkmcnt(0)" ::: "memory"); __builtin_amdgcn_s_barrier(); asm volatile("" ::: "memory");
            const int t = (wr * 4 + wc) * 64 + lane;
            if (t < 256) ss[(size_t)u.pn * MT + u.pm * BM + t] = (part[t] + part[256 + t]) + (part[512 + t] + part[768 + t]);
        }
    }
};
template <int ACCUM> struct EpiGate {
    bf16_t* MG; const bf16_t* PB; const float* ss;
    __device__ __forceinline__ void operator()(const Acc& acc, const Unit& u, int wr, int wc, int fr, int fq) const {
        const int row0 = u.pm * BM + wr * 64 + fr, col0 = u.pn * BM + wc * 32 + 8 * fq;
#pragma unroll
        for (int ai = 0; ai < 2; ++ai)
#pragma unroll
            for (int m = 0; m < 4; ++m) { const int row = row0 + ai * HALF + m * 16; const size_t ro = (size_t)row * DM + col0; const float rs = __builtin_amdgcn_rsqf(((ss[row] + ss[MT + row]) + (ss[2 * MT + row] + ss[3 * MT + row])) * (1.f / DM) + EPS);
#pragma unroll
                for (int bj = 0; bj < 2; ++bj) { const u32x4 pb = *(const u32x4*)(PB + ro + bj * HALF); u32x4 old = {0u, 0u, 0u, 0u};
                    if (ACCUM) old = *(const u32x4*)(MG + ro + bj * HALF);
                    float r[8];
#pragma unroll
                    for (int e = 0; e < 8; ++e) { const float a = acc[ai][bj][m][e >> 2][e & 3] * rs; const unsigned pw = pb[e >> 1], ow = old[e >> 1];
                        const float pv = (e & 1) ? __uint_as_float(pw & 0xffff0000u) : __uint_as_float(pw << 16);
                        const float ov = (e & 1) ? __uint_as_float(ow & 0xffff0000u) : __uint_as_float(ow << 16);
                        r[e] = sigmoidf_(a) * pv + (ACCUM ? ov : 0.f); }
                    u32x4 w; w.x = cvt_pk_bf16(r[0], r[1]); w.y = cvt_pk_bf16(r[2], r[3]); w.z = cvt_pk_bf16(r[4], r[5]); w.w = cvt_pk_bf16(r[6], r[7]);
                    *(u32x4*)(MG + ro + bj * HALF) = w; } }
    }
};

__device__ __forceinline__ void glds16_s(const void* sbase, unsigned voff, unsigned lds_dst) {
    asm volatile("s_mov_b32 m0, %2\n\ts_nop 0\n\tglobal_load_lds_dwordx4 %0, %1" :: "v"(voff), "s"(sbase), "s"(lds_dst) : "memory", "m0"); }
template <class Epi>
__device__ __forceinline__ void gemm_phase(LAS unsigned char* lds, const Gemm g, const StaticOrder& S, const Epi& E, int wave) {
    const int tid = fresh_tid(wave), wid = wave, lane = tid & 63, wr = wid >> 2, wc = wid & 3, fr = lane & 15, fq = lane >> 4;
    const int K = g.K, nt = K / BK, lda = g.lda;
    unsigned voffA[2], voffB[2];
#pragma unroll
    for (int i = 0; i < 2; ++i) { int R, C; stage_rc(tid * 16 + i * 8192, R, C); const int Rb = (R & ~31) + perm32(R & 31);
        voffA[i] = (unsigned)(R * lda + C) * 2u; voffB[i] = (unsigned)(Rb * K + C) * 2u; }
    const size_t kstep = (size_t)(BK * 2);
    const size_t hstepA = (size_t)HALF * lda * 2, hstepB = (size_t)HALF * K * 2;
    const size_t tstepA = 2 * hstepA, tstepB = 2 * hstepB;
    const unsigned ldsw = (unsigned)wid * 1024u; const unsigned lds0 = (unsigned)(__UINTPTR_TYPE__)lds;
    const int aoff = lds_byte(wr * 64 + fr, fq * 8), boff = lds_byte(wc * 32 + fr, fq * 8);
#define PG8_SA(b, h) (((b) * 2 + (h)) * HTB)
#define PG8_SB(b, h) ((4 + (b) * 2 + (h)) * HTB)
#define PG8_STAGE(bufoff, gbase, voff) do { _Pragma("unroll") for (int _i = 0; _i < 2; ++_i) \
        glds16_s((const void*)(gbase), (voff)[_i], lds0 + (unsigned)((bufoff) + _i * 8192) + ldsw); } while (0)
#define PG8_LDA(dst, b, h) do { _Pragma("unroll") for (int m = 0; m < 4; ++m) _Pragma("unroll") for (int k = 0; k < 2; ++k) dst[m][k] = *(const LAS bf16x8*)(lds + PG8_SA(b, h) + aoff + m * 2048 + k * 1024); } while (0)
#define PG8_LDB(dst, b, h) do { _Pragma("unroll") for (int n = 0; n < 2; ++n) _Pragma("unroll") for (int k = 0; k < 2; ++k) dst[n][k] = *(const LAS bf16x8*)(lds + PG8_SB(b, h) + boff + n * 2048 + k * 1024); } while (0)
#define PG8_MMA(ai, bj, At, Bt) do { __builtin_amdgcn_s_setprio(1); _Pragma("unroll") for (int m = 0; m < 4; ++m) _Pragma("unroll") for (int n = 0; n < 2; ++n) _Pragma("unroll") for (int k = 0; k < 2; ++k) \
        acc[ai][bj][m][n] = __builtin_amdgcn_mfma_f32_16x16x32_bf16(Bt[n][k], At[m][k], acc[ai][bj][m][n], 0, 0, 0); __builtin_amdgcn_s_setprio(0); } while (0)
#define PG8_WAIT_V(n) asm volatile("s_waitcnt vmcnt(" #n ")" ::: "memory")
#define PG8_WAIT_L(n) asm volatile("s_waitcnt lgkmcnt(" #n ")" ::: "memory")
#define PG8_BAR __builtin_amdgcn_s_barrier()
#define PG8_SCHED __builtin_amdgcn_sched_barrier(0)
    Unit cur, nxt; int ui = 0;
    if (!S.next(0, cur)) return;
    float zf = 0.f; asm volatile("" : "+v"(zf));
    Acc acc;
#pragma unroll
    for (int a = 0; a < 2; ++a)
#pragma unroll
        for (int b = 0; b < 2; ++b)
#pragma unroll
            for (int m = 0; m < 4; ++m)
#pragma unroll
                for (int n = 0; n < 2; ++n) acc[a][b][m][n] = (f32x4){zf, zf, zf, zf};
    bf16x8 At[4][2], B0[2][2], B1[2][2];
    const char* cA = (const char*)g.A + (size_t)cur.pm * tstepA; const char* cB = (const char*)g.Bt + (size_t)cur.pn * tstepB;
    PG8_STAGE(PG8_SB(0, 0), cB, voffB); PG8_STAGE(PG8_SB(0, 1), cB + hstepB, voffB); PG8_STAGE(PG8_SA(0, 0), cA, voffA); PG8_STAGE(PG8_SA(0, 1), cA + hstepA, voffA);
    if (wr == 1) PG8_BAR;
    PG8_WAIT_V(2); PG8_BAR;
    PG8_STAGE(PG8_SB(1, 0), cB + kstep, voffB); PG8_STAGE(PG8_SA(1, 0), cA + kstep, voffA); PG8_STAGE(PG8_SB(1, 1), cB + hstepB + kstep, voffB);
    PG8_WAIT_V(6); PG8_BAR;
    for (;;) {
        const bool has_next = S.next(ui + 1, nxt);
        const char* nA = has_next ? (const char*)g.A + (size_t)nxt.pm * tstepA : cA; const char* nB = has_next ? (const char*)g.Bt + (size_t)nxt.pn * tstepB : cB;
        for (int t = 0; t < nt; t += 2) {
            const bool last = (t == nt - 2);
            const char* a1 = cA + (size_t)(t + 1) * kstep;
            const char* a2 = last ? nA : cA + (size_t)(t + 2) * kstep; const char* b2 = last ? nB : cB + (size_t)(t + 2) * kstep;
            const char* a3 = a2 + kstep; const char* b3 = b2 + kstep;
            PG8_LDB(B0, 0, 0); PG8_LDB(B1, 0, 1); PG8_SCHED; PG8_LDA(At, 0, 0); PG8_STAGE(PG8_SA(1, 1), a1 + hstepA, voffA);
            PG8_WAIT_V(8); PG8_WAIT_L(0); PG8_BAR; PG8_MMA(0, 0, At, B0); PG8_MMA(0, 1, At, B1); PG8_BAR; PG8_SCHED;
            PG8_LDA(At, 0, 1); PG8_STAGE(PG8_SB(0, 0), b2, voffB); PG8_STAGE(PG8_SB(0, 1), b2 + hstepB, voffB); PG8_STAGE(PG8_SA(0, 0), a2, voffA);
            PG8_WAIT_V(8); PG8_WAIT_L(0); PG8_BAR; PG8_MMA(1, 0, At, B0); PG8_MMA(1, 1, At, B1); PG8_BAR; PG8_SCHED;
            PG8_LDB(B0, 1, 0); PG8_LDB(B1, 1, 1); PG8_SCHED; PG8_LDA(At, 1, 0); PG8_STAGE(PG8_SA(0, 1), a2 + hstepA, voffA);
            PG8_WAIT_V(8); PG8_WAIT_L(0); PG8_BAR; PG8_MMA(0, 0, At, B0); PG8_MMA(0, 1, At, B1); PG8_BAR; PG8_SCHED;
            PG8_LDA(At, 1, 1); PG8_STAGE(PG8_SB(1, 0), b3, voffB); PG8_STAGE(PG8_SB(1, 1), b3 + hstepB, voffB); PG8_STAGE(PG8_SA(1, 0), a3, voffA);
            PG8_WAIT_V(8); PG8_WAIT_L(0); PG8_BAR; PG8_MMA(1, 0, At, B0); PG8_MMA(1, 1, At, B1); PG8_BAR; PG8_SCHED;
        }
        if (wr == 0) PG8_BAR;
        { const int l2 = fresh_lane(); E(acc, cur, wr, wc, l2 & 15, l2 >> 4); }
        if (!has_next) break;
#pragma unroll
        for (int a = 0; a < 2; ++a)
#pragma unroll
            for (int b = 0; b < 2; ++b)
#pragma unroll
                for (int m = 0; m < 4; ++m)
#pragma unroll
                    for (int n = 0; n < 2; ++n) acc[a][b][m][n] = (f32x4){zf, zf, zf, zf};
        cur = nxt; cA = nA; cB = nB; ++ui;
        if (wr == 1) PG8_BAR;
    }
    PG8_WAIT_V(0);
    PG8_BAR;
#undef PG8_SA
#undef PG8_SB
#undef PG8_STAGE
#undef PG8_LDA
#undef PG8_LDB
#undef PG8_MMA
#undef PG8_WAIT_V
#undef PG8_WAIT_L
#undef PG8_BAR
#undef PG8_SCHED
}
}

namespace att {
typedef __bf16 bf16x2_t __attribute__((ext_vector_type(2)));
__device__ __forceinline__ unsigned cvtpk_s(float lo, float hi) { f32x2 v = {lo, hi}; bf16x2_t b = __builtin_convertvector(v, bf16x2_t); return __builtin_bit_cast(unsigned, b); }
constexpr int NW = 8, QBLK = 32, KVBLK = 64;
constexpr float THR = 8.f;
constexpr int SHM_V = 16384, SHM_K = 16384;
#define KSWZ(row, colB) ((row) * 256 + ((colB) ^ (((row) & 7) << 4)))
#define SBAR() __builtin_amdgcn_sched_barrier(0)
__device__ __forceinline__ int crow(int r, int hi) { return (r & 3) + 8 * (r >> 2) + 4 * hi; }
template <int DKB> struct Sc { static constexpr float SCALE = DKB == 4 ? 0.125f : 0.10206207261596575f; };

constexpr float THR2 = 11.5f;
__device__ __forceinline__ float rowmax32(const f32x16& p0, const f32x16& p1) {
  float pmax = p0[0];
#pragma unroll
  for (int r = 1; r < 16; ++r) pmax = fmaxf(pmax, p0[r]);
#pragma unroll
  for (int r = 0; r < 16; ++r) pmax = fmaxf(pmax, p1[r]);
  auto rr = __builtin_amdgcn_permlane32_swap(__float_as_uint(pmax), __float_as_uint(pmax), false, false);
  return fmaxf(__uint_as_float(rr[0]), __uint_as_float(rr[1]));
}
template <bool FIRST> __device__ __forceinline__ void partialSM(f32x16& p0, f32x16& p1, float& m_reg, f32x16& negm, float& alpha) {
  const float pmax = rowmax32(p0, p1);
  alpha = 1.f;
  if (FIRST) { m_reg = pmax; p0 = p0 - pmax; p1 = p1 - pmax;
#pragma unroll
    for (int r = 0; r < 16; ++r) negm[r] = -m_reg; }
  else if (__builtin_expect(!__all(pmax <= THR2), 0)) { const float dl = fmaxf(pmax, 0.f); m_reg += dl; p0 = p0 - dl; p1 = p1 - dl; alpha = __builtin_amdgcn_exp2f(-dl);
#pragma unroll
    for (int r = 0; r < 16; ++r) negm[r] = -m_reg; }
#pragma unroll
  for (int r = 0; r < 16; ++r) p0[r] = __builtin_amdgcn_exp2f(p0[r]);
}
__device__ __forceinline__ void finishSM(f32x16& p0, f32x16& p1, bf16x8& pa0, bf16x8& pa1, bf16x8& pa2, bf16x8& pa3) {
#pragma unroll
  for (int r = 0; r < 16; ++r) p1[r] = __builtin_amdgcn_exp2f(p1[r]);
#define PK4(P, BASE, OUT) do { unsigned a0 = cvtpk_s(P[BASE + 0], P[BASE + 1]), a1 = cvtpk_s(P[BASE + 2], P[BASE + 3]);   \
    unsigned b0 = cvtpk_s(P[BASE + 4], P[BASE + 5]), b1 = cvtpk_s(P[BASE + 6], P[BASE + 7]);                              \
    auto r0 = __builtin_amdgcn_permlane32_swap(a0, b0, false, false); auto r1 = __builtin_amdgcn_permlane32_swap(a1, b1, false, false); \
    u32x4 w = {r0[0], r1[0], r0[1], r1[1]}; OUT = *reinterpret_cast<bf16x8*>(&w); } while (0)
  PK4(p0, 0, pa0); PK4(p0, 8, pa1); PK4(p1, 0, pa2); PK4(p1, 8, pa3);
#undef PK4
}
template <int DKB> __device__ __forceinline__ void qkt(f32x16& p0, f32x16& p1, const char* Ks, const bf16x8* qr, const f32x16& negm, int r32, int hi) {
#pragma unroll
  for (int d0 = 0; d0 < DKB; ++d0) { int cb = (d0 * 16 + hi * 8) * 2;
    bf16x8 b0 = *reinterpret_cast<const bf16x8*>(Ks + KSWZ(r32, cb));
    bf16x8 b1 = *reinterpret_cast<const bf16x8*>(Ks + KSWZ(32 + r32, cb));
    if (d0 == 0) { p0 = __builtin_amdgcn_mfma_f32_32x32x16_bf16(b0, qr[0], negm, 0, 0, 0); p1 = __builtin_amdgcn_mfma_f32_32x32x16_bf16(b1, qr[0], negm, 0, 0, 0); }
    else { p0 = __builtin_amdgcn_mfma_f32_32x32x16_bf16(b0, qr[d0], p0, 0, 0, 0); p1 = __builtin_amdgcn_mfma_f32_32x32x16_bf16(b1, qr[d0], p1, 0, 0, 0); } }
}
__device__ __forceinline__ int v_st(int k, int c) { const int kk = (k & ~0xC) | ((k & 4) << 1) | ((k & 8) >> 1); return ((kk >> 3) * 4 + (c >> 5)) * 512 + ((kk & 7) * 32 + (c & 31)) * 2; }
__device__ __forceinline__ int v_rd_base(int lane) { return ((lane & 3) << 3) | (((lane >> 2) & 3) << 6) | (((lane >> 4) & 1) << 5) | (((lane >> 5) & 1) << 8); }
constexpr int v_rd_off(int d0, int ks, int half) { return d0 * 512 + ks * 4096 + half * 2048; }
template <int OFF> __device__ __forceinline__ s16x4 tr_read(int vb) {
  s16x4 r; asm volatile("ds_read_b64_tr_b16 %0, %1 offset:%2" : "=&v"(r) : "v"(vb), "i"(OFF) : "memory"); return r;
}
template <int D0> __device__ __forceinline__ void pv_one(f32x16& od, int vb, bf16x8 pa0, bf16x8 pa1, bf16x8 pa2, bf16x8 pa3) {
  const s16x4 l0 = tr_read<v_rd_off(D0, 0, 0)>(vb), h0 = tr_read<v_rd_off(D0, 0, 1)>(vb), l1 = tr_read<v_rd_off(D0, 1, 0)>(vb), h1 = tr_read<v_rd_off(D0, 1, 1)>(vb);
  const s16x4 l2 = tr_read<v_rd_off(D0, 2, 0)>(vb), h2 = tr_read<v_rd_off(D0, 2, 1)>(vb), l3 = tr_read<v_rd_off(D0, 3, 0)>(vb), h3 = tr_read<v_rd_off(D0, 3, 1)>(vb);
  asm volatile("s_waitcnt lgkmcnt(0)" ::: "memory"); SBAR();
#define PK(L, H) (bf16x8){L[0], L[1], L[2], L[3], H[0], H[1], H[2], H[3]}
  od = __builtin_amdgcn_mfma_f32_32x32x16_bf16(pa0, PK(l0, h0), od, 0, 0, 0);
  od = __builtin_amdgcn_mfma_f32_32x32x16_bf16(pa1, PK(l1, h1), od, 0, 0, 0);
  od = __builtin_amdgcn_mfma_f32_32x32x16_bf16(pa2, PK(l2, h2), od, 0, 0, 0);
  od = __builtin_amdgcn_mfma_f32_32x32x16_bf16(pa3, PK(l3, h3), od, 0, 0, 0);
#undef PK
}
__device__ __forceinline__ void pv_d0(f32x16* o, int vb, bf16x8 pa0, bf16x8 pa1, bf16x8 pa2, bf16x8 pa3) {
  const bf16x8 ones = {16256, 16256, 16256, 16256, 16256, 16256, 16256, 16256};
  pv_one<0>(o[0], vb, pa0, pa1, pa2, pa3);
  o[2] = __builtin_amdgcn_mfma_f32_32x32x16_bf16(pa0, ones, o[2], 0, 0, 0); o[2] = __builtin_amdgcn_mfma_f32_32x32x16_bf16(pa1, ones, o[2], 0, 0, 0);
  pv_one<1>(o[1], vb, pa0, pa1, pa2, pa3);
  o[2] = __builtin_amdgcn_mfma_f32_32x32x16_bf16(pa2, ones, o[2], 0, 0, 0); o[2] = __builtin_amdgcn_mfma_f32_32x32x16_bf16(pa3, ones, o[2], 0, 0, 0);
}
template <int DKB>
__device__ __forceinline__ void attn_unit(const bf16_t* Qb, int ldq, const bf16_t* K1, int ldk1, const bf16_t* K2, int ldk2, const bf16_t* Vh, int ldv, bf16_t* Ob, int ldo, int seq, char* lds, int tq0, const f32x2* tab, int wave) {
  const int tid = fresh_tid(wave), wid = wave, lane = tid & 63, r32 = lane & 31, hi = lane >> 5;
  char* V_lds = lds; char* K_lds = lds + 3 * SHM_V;
  float* ws = (float*)(lds + 3 * SHM_V + 3 * SHM_K) + wid * 64; float* al_l = ws + 32;
  float m_reg = 0.f; f32x16 o[3] = {}; bf16x8 qr[DKB]; f32x16 negm = {};
  constexpr float QC = Sc<DKB>::SCALE * 1.4426950408889634f;
  const bf16_t* Qw = Qb + (long)(wid * QBLK + r32) * ldq + hi * 8;
#pragma unroll
  for (int d0 = 0; d0 < DKB; ++d0) { u32x4 w = *reinterpret_cast<const u32x4*>(Qw + d0 * 16);
    if (DKB == 6 && d0 >= 4) {
      const int tq = tq0 + wid * QBLK + r32; const f32x2* tb = tab + (d0 == 4 ? (tq >> 6) : (tq & 63)) * 8 + hi * 4;
#pragma unroll
      for (int e = 0; e < 4; ++e) { const f32x2 cs = tb[e]; const float x0 = __uint_as_float(w[e] << 16), x1 = __uint_as_float(w[e] & 0xffff0000u);
        w[e] = cvt_pk_bf16((x0 * cs.x - x1 * cs.y) * QC, (x0 * cs.y + x1 * cs.x) * QC); }
    } else {
#pragma unroll
      for (int e = 0; e < 4; ++e) w[e] = cvt_pk_bf16(__uint_as_float(w[e] << 16) * QC, __uint_as_float(w[e] & 0xffff0000u) * QC); }
    qr[d0] = *reinterpret_cast<bf16x8*>(&w); }
  const int sr = tid >> 3, sc = (tid & 7) * 8, vst0 = v_st(sr, sc), kst0 = KSWZ(sr, sc * 2);
  const int sr2 = (tid & 255) >> 2, sc2 = (tid & 3) * 8, kst2 = KSWZ(sr2, (64 + sc2) * 2);
  const int vb0 = (int)(uintptr_t)V_lds + v_rd_base(lane);
  struct { bf16x8 vs, ks, k2; } sr_[2];
#define SLOAD(i, k0) do { sr_[i].vs = *reinterpret_cast<const bf16x8*>(&Vh[(long)((k0) + sr) * ldv + sc]); sr_[i].ks = *reinterpret_cast<const bf16x8*>(&K1[(long)((k0) + sr) * ldk1 + sc]); \
    if (DKB == 6) sr_[i].k2 = *reinterpret_cast<const bf16x8*>(&K2[(long)((k0) + sr2) * ldk2 + sc2]); } while (0)
#define SWRITE(off, i) do { *(bf16x8*)(V_lds + (off) + vst0) = sr_[i].vs; *(bf16x8*)(K_lds + (off) + kst0) = sr_[i].ks; \
    if (DKB == 6) *(bf16x8*)(K_lds + (off) + kst2) = sr_[i].k2; } while (0)
#define SWAIT() do { if (DKB == 6) asm volatile("s_waitcnt vmcnt(3)" ::: "memory"); else asm volatile("s_waitcnt vmcnt(2)" ::: "memory"); } while (0)
#define RESC(a) do { if (__any((a) < 1.f)) { if (hi == 0) al_l[r32] = (a); asm volatile("s_waitcnt lgkmcnt(0)" ::: "memory"); \
    _Pragma("unroll") for (int d = 0; d < 3; ++d) _Pragma("unroll") for (int r = 0; r < 16; ++r) o[d][r] *= al_l[crow(r, hi)]; } } while (0)
#define ROT() do { o_prev = o_cur; o_cur = o_next; o_next = (o_next == 2 * SLOT) ? 0 : o_next + SLOT; } while (0)
  constexpr int SLOT = 16384;
  f32x16 pA0, pA1, pB0, pB1; float alA, alB; bf16x8 pa0, pa1, pa2, pa3; const int NT = seq / KVBLK;
  constexpr int SE = 0, SO = 1;
  int o_prev = 0, o_cur = 0, o_next = SLOT;
  SLOAD(SE, 0); asm volatile("s_waitcnt vmcnt(0)" ::: "memory"); SWRITE(0, SE); __syncthreads();
  qkt<DKB>(pA0, pA1, K_lds, qr, negm, r32, hi); partialSM<true>(pA0, pA1, m_reg, negm, alA);
  SLOAD(SO, KVBLK); if (2 < NT) SLOAD(SE, 2 * KVBLK);
  SWAIT(); SWRITE(SLOT, SO); __syncthreads();
  ROT();
  for (int j = 1; j + 1 < NT; j += 2) {
    SBAR(); qkt<DKB>(pB0, pB1, K_lds + o_cur, qr, negm, r32, hi);
    finishSM(pA0, pA1, pa0, pa1, pa2, pa3); SBAR();
    SLOAD(SO, (j + 2) * KVBLK); SBAR();
    pv_d0(o, vb0 + o_prev, pa0, pa1, pa2, pa3); partialSM<false>(pB0, pB1, m_reg, negm, alB);
    SWAIT(); SWRITE(o_next, SE);
    RESC(alB); __syncthreads(); ROT();
    SBAR(); qkt<DKB>(pA0, pA1, K_lds + o_cur, qr, negm, r32, hi);
    finishSM(pB0, pB1, pa0, pa1, pa2, pa3); SBAR();
    if (j + 3 < NT) SLOAD(SE, (j + 3) * KVBLK); SBAR();
    pv_d0(o, vb0 + o_prev, pa0, pa1, pa2, pa3); partialSM<false>(pA0, pA1, m_reg, negm, alA);
    SWAIT(); SWRITE(o_next, SO);
    RESC(alA); __syncthreads(); ROT();
  }
  SBAR(); qkt<DKB>(pB0, pB1, K_lds + o_cur, qr, negm, r32, hi);
  finishSM(pA0, pA1, pa0, pa1, pa2, pa3); SBAR();
  pv_d0(o, vb0 + o_prev, pa0, pa1, pa2, pa3); partialSM<false>(pB0, pB1, m_reg, negm, alB);
  RESC(alB);
  finishSM(pB0, pB1, pa0, pa1, pa2, pa3); SBAR();
  pv_d0(o, vb0 + o_cur, pa0, pa1, pa2, pa3);
  float rli[16];
#pragma unroll
  for (int r = 0; r < 16; ++r) rli[r] = __builtin_amdgcn_rcpf(o[2][r]);
  bf16_t* Ow = Ob + (long)(wid * QBLK) * ldo;
#pragma unroll
  for (int r = 0; r < 16; ++r) { int orow = crow(r, hi);
#pragma unroll
    for (int d0 = 0; d0 < 2; ++d0) Ow[(long)orow * ldo + d0 * 32 + r32] = (bf16_t)f2bf(o[d0][r] * rli[r]); }
  __syncthreads();
#undef SLOAD
#undef SWRITE
#undef SWAIT
#undef RESC
#undef ROT
}
#undef SBAR
}

struct Ctx { int wave, G, bid; };
#define CTX_GW(c) ((c).bid * 8 + (c).wave)
#define CTX_NGW(c) ((c).G * 8)
#define CTX_VCU(c) (((c).G % 8 == 0) ? ((c).bid % 8) * ((c).G / 8) + (c).bid / 8 : (c).bid)
#define LOCAL_TID const int tid = c.wave * 64 + fresh_lane(); const int lane = tid & 63; (void)lane;

__device__ __forceinline__ void tr_item(const float* W, int ldw, int Kd, int k0, int n0, bf16_t* WT, int drow0, LAS float* scr, int lane) {
#pragma unroll 8
    for (int i = 0; i < 32; ++i) { const int kk = 2 * i + (lane >> 5); scr[kk * 33 + (lane & 31)] = W[(size_t)(k0 + kk) * ldw + n0 + (lane & 31)]; }
    asm volatile("s_waitcnt lgkmcnt(0)" ::: "memory");
    const int c = lane & 7;
#pragma unroll
    for (int j = 0; j < 4; ++j) { const int n = (lane >> 3) + 8 * j; const LAS float* s = scr + (8 * c) * 33 + n;
        u32x4 o; o.x = pk2(s[0 * 33], s[1 * 33]); o.y = pk2(s[2 * 33], s[3 * 33]); o.z = pk2(s[4 * 33], s[5 * 33]); o.w = pk2(s[6 * 33], s[7 * 33]);
        *(u32x4*)(WT + (size_t)(drow0 + n) * Kd + k0 + 8 * c) = o; }
    asm volatile("s_waitcnt lgkmcnt(0)" ::: "memory");
}
struct LayerW { const float *gate1, *up1, *dn1, *win, *uq, *ukv, *br, *wout, *gate2, *up2, *dn2; };
__device__ __forceinline__ void convert_weights(const Ctx& c, const LayerW& w, bf16_t* WB, LAS unsigned char* lds) {
    LOCAL_TID
    LAS float* scr = (LAS float*)(lds + c.wave * 16384);
    constexpr int I_G = 16 * 88, I_D = 44 * 32, I_IN = 16 * 85, I_GT = 16 * 96, I_UQ = 4 * 24, I_UKV = 2 * 32, I_BR = 8 * 32, I_OUT = 16 * 32;
    constexpr int NITEMS = 4 * I_G + 2 * I_D + I_IN + I_GT + I_UQ + I_UKV + 3 * I_BR + I_OUT;
    for (int it = CTX_GW(c); it < NITEMS; it += CTX_NGW(c)) {
        int r = it;
#define FFN_GU(src, dst, upofs) { const int kb = r / 88, nb = r % 88, n0 = nb * 32; tr_item(src, DFF, DM, kb * 64, n0, dst, (n0 >> 7) * 256 + (upofs) + (n0 & 127), scr, lane); }
        if (r < I_G) { FFN_GU(w.gate1, WB + WO_GU1, 0); continue; } r -= I_G;
        if (r < I_G) { FFN_GU(w.up1, WB + WO_GU1, 128); continue; } r -= I_G;
        if (r < I_G) { FFN_GU(w.gate2, WB + WO_GU2, 0); continue; } r -= I_G;
        if (r < I_G) { FFN_GU(w.up2, WB + WO_GU2, 128); continue; } r -= I_G;
#undef FFN_GU
        if (r < I_D) { const int kb = r / 32, nb = r % 32; tr_item(w.dn1, DM, DFF, kb * 64, nb * 32, WB + WO_DN1, nb * 32, scr, lane); continue; } r -= I_D;
        if (r < I_D) { const int kb = r / 32, nb = r % 32; tr_item(w.dn2, DM, DFF, kb * 64, nb * 32, WB + WO_DN2, nb * 32, scr, lane); continue; } r -= I_D;
        if (r < I_IN) { const int kb = r / 85, nb = r % 85; tr_item(w.win, 5792, DM, kb * 64, nb * 32, WB + WO_IN, nb * 32, scr, lane); continue; } r -= I_IN;
        if (r < I_GT) { const int kb = r / 96, nb = r % 96; tr_item(w.win, 5792, DM, kb * 64, 2720 + nb * 32, WB + WO_GATE, nb * 32, scr, lane); continue; } r -= I_GT;
        if (r < I_UQ) { const int kb = r / 24, nb = r % 24; tr_item(w.uq, 768, 256, kb * 64, nb * 32, WB + WO_UQ, nb * 32, scr, lane); continue; } r -= I_UQ;
        if (r < I_UKV) { const int kb = r / 32, nb = r % 32; tr_item(w.ukv, 1024, 128, kb * 64, nb * 32, WB + WO_UKV, nb * 32, scr, lane); continue; } r -= I_UKV;
        if (r < 3 * I_BR) { const int bi = r / I_BR, q = r % I_BR, kb = q / 32, nb = q % 32; tr_item(w.br + (size_t)bi * 512 * 1024, DM, 512, kb * 64, nb * 32, WB + WO_BR + (size_t)bi * 1024 * 512, nb * 32, scr, lane); continue; } r -= 3 * I_BR;
        { const int kb = r / 32, nb = r % 32; tr_item(w.wout, DM, DM, kb * 64, nb * 32, WB + WO_OUT, nb * 32, scr, lane); }
    }
    { unsigned zz = 0u; asm volatile("" : "+v"(zz));
      for (int i = c.bid * 512 + tid; i < 96 * 1024 / 8; i += c.G * 512) ((u32x4*)(WB + WO_IN + (size_t)2720 * 1024))[i] = (u32x4){zz, zz, zz, zz}; }
}

template <int MODE>
__device__ __forceinline__ void norm_rows(const Ctx& c, const float* xp, const float* xs, float* xbuf, const float* g, bf16_t* XN) {
    LOCAL_TID
    const f32x4* g4 = (const f32x4*)g + lane;
    f32x4 gv[4];
#pragma unroll
    for (int j = 0; j < 4; ++j) gv[j] = g4[64 * j];
    constexpr int RB = 4;
    for (int m0 = CTX_GW(c); m0 < MT; m0 += RB * CTX_NGW(c)) {
        f32x4 v[RB][4];
#pragma unroll
        for (int q = 0; q < RB; ++q) { const int m = m0 + q * CTX_NGW(c); if (m < MT) {
            const float* src = (MODE == 1) ? (m < MP ? xp + (size_t)m * DM : xs + (size_t)(m - MP) * DM) : xbuf + (size_t)m * DM;
            const f32x4* xr = (const f32x4*)src + lane;
#pragma unroll
            for (int j = 0; j < 4; ++j) v[q][j] = xr[64 * j]; } }
#pragma unroll
        for (int q = 0; q < RB; ++q) { const int m = m0 + q * CTX_NGW(c); if (m < MT) {
            float s = 0.f;
#pragma unroll
            for (int j = 0; j < 4; ++j) s += (v[q][j].x * v[q][j].x + v[q][j].y * v[q][j].y) + (v[q][j].z * v[q][j].z + v[q][j].w * v[q][j].w);
            const float rstd = 1.0f / sqrtf(wave_sum(s, lane) * (1.f / DM) + EPS);
            if (MODE == 2) { f32x4* xo = (f32x4*)(xbuf + (size_t)m * DM) + lane;
#pragma unroll
                for (int j = 0; j < 4; ++j) xo[64 * j] = v[q][j] * rstd * gv[j]; }
            else { u32x2* o8 = (u32x2*)(XN + (size_t)m * DM) + lane;
#pragma unroll
                for (int j = 0; j < 4; ++j) { const f32x4 y = v[q][j] * rstd * gv[j]; u32x2 w; w.x = pk2(y.x, y.y); w.y = pk2(y.z, y.w); o8[64 * j] = w; } } } }
    }
}

__device__ __forceinline__ void misc_tables(const Ctx& c, unsigned char* ws, const float* w1, const float* b1, const float* w2, const float* b2, const float* freq) {
    LOCAL_TID
    f32x2* T2 = (f32x2*)(ws + WS_T2); f32x2* tabA = (f32x2*)(ws + WS_TABA); f32x2* tabM = (f32x2*)(ws + WS_TABM);
    const int gt = c.bid * 512 + tid, NT = c.G * 512;
    for (int j = gt; j < 8192; j += NT) { const float a = (float)j * (1.0f / 8192.0f); T2[j] = (f32x2){cospif(a), -sinpif(a)}; }
    for (int i = gt; i < 128 * 16; i += NT) { const int pos = i >> 4, f = i & 15; const float inv = powf(10000.0f, -(float)f / 16.0f); const float a = (float)pos * inv; tabA[i] = (f32x2){cosf(a), sinf(a)}; }
    for (int i = gt; i < 128 * 8; i += NT) { const int pos = i >> 3, f = i & 7; const float inv = powf(10000.0f, -(float)f / 8.0f); const float a = (float)pos * inv; tabM[i] = (f32x2){cosf(a), sinf(a)}; }
    for (int r = CTX_GW(c); r < 2 * 12288; r += CTX_NGW(c)) {
        const int l = r / 12288, q = r % 12288; const int L = q < 8192 ? 8192 : 4096; const int t = q < 8192 ? q : q - 8192;
        float* H2 = (float*)(ws + WS_H2 + (size_t)l * 3 * MiB) + (q < 8192 ? 0 : 8192 * 64) + (size_t)t * 64;
        const float tl = (float)t / (float)(L - 1); const float wv = 6.283185307179586f * (float)t / (float)L;
        float z = 0.f;
        if (lane == 0) z = tl;
        else if (lane < 33) { const int k = (lane - 1) & 15; const float f = 1e-4f + (float)k * ((15.0f - 1e-4f) / 15.0f); z = lane < 17 ? cosf(f * wv) : -sinf(f * wv); }
        const float* W1 = w1 + l * 33 * 64; const float* W2 = w2 + l * 64 * 64; const float fr = freq[l * 64 + lane];
        float a = b1[l * 64 + lane];
#pragma unroll
        for (int i = 0; i < 33; ++i) a += bcast_l(z, i) * W1[i * 64 + lane];
        const float h1 = sinf(fr * a);
        float a2 = b2[l * 64 + lane];
#pragma unroll 8
        for (int k = 0; k < 64; ++k) a2 += bcast_l(h1, k) * W2[k * 64 + lane];
        H2[lane] = sinf(fr * a2);
    }
}

__device__ __forceinline__ void tok_local(const Ctx& c, bf16_t* ZC, const float* gq, const float* gk, const float* gmq, const float* gmkv, const f32x2* tabA, const f32x2* tabM) {
    LOCAL_TID
    constexpr int RB = 4;
    for (int m0 = CTX_GW(c); m0 < MT; m0 += RB * CTX_NGW(c)) {
        unsigned raw[RB][9];
#pragma unroll
        for (int q = 0; q < RB; ++q) { const int m = m0 + q * CTX_NGW(c); if (m < MT) { const unsigned* zr = (const unsigned*)(ZC + (size_t)m * ZCW);
#pragma unroll
            for (int it = 0; it < 5; ++it) raw[q][it] = zr[it * 64 + lane];
            raw[q][5] = zr[C_CQ / 2 + lane]; raw[q][6] = zr[C_CQ / 2 + 64 + lane]; raw[q][7] = zr[C_CKV / 2 + lane]; raw[q][8] = zr[C_KR / 2 + (lane & 15)]; } }
#pragma unroll
        for (int q = 0; q < RB; ++q) { const int m = m0 + q * CTX_NGW(c); if (m < MT) {
        unsigned* zr = (unsigned*)(ZC + (size_t)m * ZCW); const int t = m < MP ? (m & (LP - 1)) : (m & (LS - 1));
#pragma unroll
        for (int it = 0; it < 5; ++it) { const int pidx = it * 64 + lane, head = pidx >> 5, pi = pidx & 31;
            const unsigned rw = raw[q][it]; const float x0 = bf2f(rw & 0xffffu), x1 = bf2f(rw >> 16);
            float ss = x0 * x0 + x1 * x1;
#pragma unroll
            for (int o = 1; o < 32; o <<= 1) ss += shfl_xor_l(ss, o, lane);
            const float r = 1.0f / sqrtf(ss * (1.f / 64.f) + EPS); const float* g = head < 8 ? gq : gk;
            const float n0 = x0 * r * g[2 * pi], n1 = x1 * r * g[2 * pi + 1];
            const int pos = pi < 16 ? (t >> 6) : (t & 63); const f32x2 cs = tabA[pos * 16 + (pi & 15)];
            zr[pidx] = pk2(n0 * cs.x - n1 * cs.y, n0 * cs.y + n1 * cs.x); }
        { const unsigned r0 = raw[q][5], r1 = raw[q][6];
          const float a0 = bf2f(r0 & 0xffffu), a1 = bf2f(r0 >> 16), b0 = bf2f(r1 & 0xffffu), b1 = bf2f(r1 >> 16);
          const float r = 1.0f / sqrtf(wave_sum(a0 * a0 + a1 * a1 + b0 * b0 + b1 * b1, lane) * (1.f / 256.f) + EPS);
          zr[C_CQ / 2 + lane] = pk2(a0 * r * gmq[2 * lane], a1 * r * gmq[2 * lane + 1]); zr[C_CQ / 2 + 64 + lane] = pk2(b0 * r * gmq[128 + 2 * lane], b1 * r * gmq[128 + 2 * lane + 1]); }
        { const unsigned r0 = raw[q][7]; const float a0 = bf2f(r0 & 0xffffu), a1 = bf2f(r0 >> 16);
          const float r = 1.0f / sqrtf(wave_sum(a0 * a0 + a1 * a1, lane) * (1.f / 128.f) + EPS);
          zr[C_CKV / 2 + lane] = pk2(a0 * r * gmkv[2 * lane], a1 * r * gmkv[2 * lane + 1]); }
        if (lane < 16) { const unsigned r0 = raw[q][8]; const float x0 = bf2f(r0 & 0xffffu), x1 = bf2f(r0 >> 16);
          const int pos = lane < 8 ? (t >> 6) : (t & 63); const f32x2 cs = tabM[pos * 8 + (lane & 7)];
          zr[C_KR / 2 + lane] = pk2(x0 * cs.x - x1 * cs.y, x0 * cs.y + x1 * cs.x); }
        } }
    }
}

__device__ __forceinline__ void short_conv8(const bf16_t* ZC, int m, int t, int L, int col, const float* wsh, const float* bsh, int hc, float* out) {
    const u32x4 zc = *(const u32x4*)(ZC + (size_t)m * ZCW + col);
    u32x4 zm = {0u, 0u, 0u, 0u}, zp = {0u, 0u, 0u, 0u};
    if (t > 0) zm = *(const u32x4*)(ZC + (size_t)(m - 1) * ZCW + col);
    if (t < L - 1) zp = *(const u32x4*)(ZC + (size_t)(m + 1) * ZCW + col);
#pragma unroll
    for (int e = 0; e < 8; ++e) { const unsigned a = zm[e >> 1], b = zc[e >> 1], d = zp[e >> 1];
        const float xm = (e & 1) ? __uint_as_float(a & 0xffff0000u) : __uint_as_float(a << 16);
        const float xc = (e & 1) ? __uint_as_float(b & 0xffff0000u) : __uint_as_float(b << 16);
        const float xp = (e & 1) ? __uint_as_float(d & 0xffff0000u) : __uint_as_float(d << 16);
        out[e] = xm * wsh[hc + e] + xc * wsh[1536 + hc + e] + xp * wsh[3072 + hc + e] + bsh[hc + e]; }
}
__device__ __forceinline__ void hy_fwd_tiles(const Ctx& c, const bf16_t* ZC, bf16_t* ST, const float* wsh, const float* bsh, LAS unsigned char* lds) {
    LOCAL_TID
    LAS bf16_t* T = (LAS bf16_t*)lds;
    const int tt = tid >> 3, cgp = tid & 7;
    for (int tile = c.bid; tile < (MT / 256) * 8; tile += c.G) {
        const int c0 = (tile & 7) * 64, mb = (tile >> 3) * 256; const int L = mb < MP ? LP : LS; const int ch = c0 + cgp * 8;
#pragma unroll
        for (int q = 0; q < 4; ++q) { const int m0 = mb + q * 64, t0 = m0 & (L - 1); const int m = m0 + tt, t = t0 + tt;
            float a[8], b[8];
            short_conv8(ZC, m, t, L, C_HY + 512 + ch, wsh, bsh, 512 + ch, a);
            short_conv8(ZC, m, t, L, C_HY + 1024 + ch, wsh, bsh, 1024 + ch, b);
#pragma unroll
            for (int e = 0; e < 8; ++e) T[q * 4608 + (cgp * 8 + e) * 72 + tt] = (bf16_t)f2bf(a[e] * b[e]); }
        __syncthreads();
#pragma unroll
        for (int q = 0; q < 4; ++q) { const int m0 = mb + q * 64, t0 = m0 & (L - 1), rb = m0 - t0; const int cl = tid >> 3, tch = tid & 7;
            const u32x4 v = *(const LAS u32x4*)(T + q * 4608 + cl * 72 + tch * 8);
            *(u32x4*)(ST + (size_t)rb * 512 + (size_t)(c0 + cl) * L + t0 + tch * 8) = v; }
        __syncthreads();
    }
}
__device__ __forceinline__ void hy_bwd_tiles(const Ctx& c, bf16_t* ZC, const bf16_t* ST, const float* wsh, const float* bsh, LAS unsigned char* lds) {
    LOCAL_TID
    LAS bf16_t* T = (LAS bf16_t*)lds;
    const int tt = tid >> 3, cgp = tid & 7;
    for (int tile = c.bid; tile < (MT / 256) * 8; tile += c.G) {
        const int c0 = (tile & 7) * 64, mb = (tile >> 3) * 256; const int L = mb < MP ? LP : LS; const int ch = c0 + cgp * 8;
#pragma unroll
        for (int q = 0; q < 4; ++q) { const int m0 = mb + q * 64, t0 = m0 & (L - 1), rb = m0 - t0; const int cl = tid >> 3, tch = tid & 7;
            const u32x4 v = *(const u32x4*)(ST + (size_t)rb * 512 + (size_t)(c0 + cl) * L + t0 + tch * 8);
            *(LAS u32x4*)(T + q * 4608 + cl * 72 + tch * 8) = v; }
        __syncthreads();
#pragma unroll
        for (int q = 0; q < 4; ++q) { const int m0 = mb + q * 64, t0 = m0 & (L - 1); const int m = m0 + tt, t = t0 + tt;
            float a[8];
            short_conv8(ZC, m, t, L, C_HY + ch, wsh, bsh, ch, a);
            float r[8];
#pragma unroll
            for (int e = 0; e < 8; ++e) r[e] = a[e] * bf2f(T[q * 4608 + (cgp * 8 + e) * 72 + tt]);
            u32x4 w; w.x = pk2(r[0], r[1]); w.y = pk2(r[2], r[3]); w.z = pk2(r[4], r[5]); w.w = pk2(r[6], r[7]);
            *(u32x4*)(ZC + (size_t)m * ZCW + C_YB + ch) = w; }
        __syncthreads();
    }
}

__device__ __forceinline__ float fadd_(float a, float b) { float r; asm("v_add_f32_e32 %0, %1, %2" : "=v"(r) : "v"(a), "v"(b)); return r; }
__device__ __forceinline__ float fsub_(float a, float b) { float r; asm("v_sub_f32_e32 %0, %1, %2" : "=v"(r) : "v"(a), "v"(b)); return r; }
__device__ __forceinline__ float fmul_(float a, float b) { float r; asm("v_mul_f32_e32 %0, %1, %2" : "=v"(r) : "v"(a), "v"(b)); return r; }
__device__ __forceinline__ float ffma_(float a, float b, float c) { float r; asm("v_fma_f32 %0, %1, %2, %3" : "=v"(r) : "v"(a), "v"(b), "v"(c)); return r; }
__device__ __forceinline__ float fnma_(float a, float b, float c) { float r; asm("v_fma_f32 %0, -%1, %2, %3" : "=v"(r) : "v"(a), "v"(b), "v"(c)); return r; }
__device__ __forceinline__ f32x2 cadd(f32x2 a, f32x2 b) { return (f32x2){fadd_(a.x, b.x), fadd_(a.y, b.y)}; }
__device__ __forceinline__ f32x2 csub(f32x2 a, f32x2 b) { return (f32x2){fsub_(a.x, b.x), fsub_(a.y, b.y)}; }
__device__ __forceinline__ f32x2 cscale(f32x2 a, float s) { return (f32x2){fmul_(a.x, s), fmul_(a.y, s)}; }
__device__ __forceinline__ f32x2 cmul(f32x2 a, f32x2 b) { return (f32x2){fnma_(a.y, b.y, fmul_(a.x, b.x)), ffma_(a.y, b.x, fmul_(a.x, b.y))}; }
__device__ __forceinline__ f32x2 cmulc(f32x2 a, f32x2 b) { return (f32x2){ffma_(a.y, b.y, fmul_(a.x, b.x)), fnma_(a.x, b.y, fmul_(a.y, b.x))}; }
__device__ __forceinline__ int PADI(int i) { return i + (i >> 4); }
__device__ __forceinline__ constexpr float c16f(int m) { return m == 0 ? 1.f : m == 1 ? 0.92387953251128674f : m == 2 ? 0.70710678118654752f : m == 3 ? 0.38268343236508977f : m == 4 ? 0.f : m == 5 ? -0.38268343236508977f : m == 6 ? -0.70710678118654752f : -0.92387953251128674f; }
__device__ __forceinline__ constexpr float s16f(int m) { return m == 0 ? 0.f : m == 1 ? 0.38268343236508977f : m == 2 ? 0.70710678118654752f : m == 3 ? 0.92387953251128674f : m == 4 ? 1.f : m == 5 ? 0.92387953251128674f : m == 6 ? 0.70710678118654752f : 0.38268343236508977f; }
#define CW16(m) ((f32x2){(m) == 0 ? 1.f : (m) == 1 ? k1 : (m) == 2 ? k2 : (m) == 3 ? k3 : (m) == 4 ? 0.f : (m) == 5 ? -k3 : (m) == 6 ? -k2 : -k1, (m) == 0 ? 0.f : (m) == 1 ? -k3 : (m) == 2 ? -k2 : (m) == 3 ? -k1 : (m) == 4 ? -1.f : (m) == 5 ? -k1 : (m) == 6 ? -k2 : -k3})
template <int R, bool UNIT> __device__ __forceinline__ void dif_regs(f32x2* v, f32x2 wb) {
    float k1 = 0.92387953251128674f, k2 = 0.70710678118654752f, k3 = 0.38268343236508977f; asm volatile("" : "+v"(k1), "+v"(k2), "+v"(k3));
#pragma unroll
    for (int t = 0; t < R; ++t) { constexpr int dummy = 0; (void)dummy; const int half = 1 << (R - 1 - t);
#pragma unroll
        for (int k = 0; k < (1 << R); ++k) if (!(k & half)) { const int kk = k & (half - 1), m = kk * (8 / half);
            const f32x2 a = v[k], b = v[k + half]; v[k] = cadd(a, b); const f32x2 d = csub(a, b);
            if (UNIT) { v[k + half] = (m == 0) ? d : (m == 4) ? (f32x2){d.y, -d.x} : cmul(d, CW16(m)); }
            else { const f32x2 tw = (m == 0) ? wb : cmul(wb, CW16(m)); v[k + half] = cmul(d, tw); } }
        if (!UNIT) wb = cmul(wb, wb); }
}
template <int R, bool UNIT> __device__ __forceinline__ void dit_regs(f32x2* v, f32x2 wbig) {
    float k1 = 0.92387953251128674f, k2 = 0.70710678118654752f, k3 = 0.38268343236508977f; asm volatile("" : "+v"(k1), "+v"(k2), "+v"(k3));
    f32x2 wbs[R]; wbs[R - 1] = wbig;
#pragma unroll
    for (int t = R - 2; t >= 0; --t) wbs[t] = cmul(wbs[t + 1], wbs[t + 1]);
#pragma unroll
    for (int t = 0; t < R; ++t) { const int half = 1 << t;
#pragma unroll
        for (int k = 0; k < (1 << R); ++k) if (!(k & half)) { const int kk = k & (half - 1), m = kk * (8 / half);
            const f32x2 a = v[k]; f32x2 b = v[k + half];
            if (UNIT) { if (m == 4) b = (f32x2){-b.y, b.x}; else if (m != 0) b = cmulc(b, CW16(m)); }
            else { const f32x2 tw = (m == 0) ? wbs[t] : cmul(wbs[t], CW16(m)); b = cmulc(b, tw); }
            v[k] = cadd(a, b); v[k + half] = csub(a, b); } }
}
template <int R> __device__ __forceinline__ void dif_pass_rt(LAS f32x2* X, int sl, const f32x2 wb_in, int tid) {
    float wbx = wb_in.x, wby = wb_in.y; asm volatile("" : "+v"(wbx), "+v"(wby)); const f32x2 wb = {wbx, wby};
    const int r = tid & ((1 << sl) - 1), base = ((tid >> sl) << (sl + R)) + r;
    LAS f32x2* Xb = X + PADI(base); f32x2 v[1 << R];
#pragma unroll
    for (int k = 0; k < (1 << R); ++k) v[k] = Xb[(k << sl) + ((k << sl) >> 4)];
    dif_regs<R, false>(v, wb);
#pragma unroll
    for (int k = 0; k < (1 << R); ++k) Xb[(k << sl) + ((k << sl) >> 4)] = v[k];
}
template <int R> __device__ __forceinline__ void dit_pass_rt(LAS f32x2* X, int sl, const f32x2 wb_in, int tid) {
    float wbx = wb_in.x, wby = wb_in.y; asm volatile("" : "+v"(wbx), "+v"(wby)); const f32x2 wbig = {wbx, wby};
    const int r = tid & ((1 << sl) - 1), base = ((tid >> sl) << (sl + R)) + r;
    LAS f32x2* Xb = X + PADI(base); f32x2 v[1 << R];
#pragma unroll
    for (int k = 0; k < (1 << R); ++k) v[k] = Xb[(k << sl) + ((k << sl) >> 4)];
    dit_regs<R, false>(v, wbig);
#pragma unroll
    for (int k = 0; k < (1 << R); ++k) Xb[(k << sl) + ((k << sl) >> 4)] = v[k];
}
template <int NPT> __device__ __forceinline__ int pass_sl(int ps) { return NPT == 16 ? (ps == 0 ? 9 : ps == 1 ? 5 : 1) : (ps == 0 ? 9 : ps == 1 ? 6 : 3); }
template <int NPT> __device__ __forceinline__ void fwd2_to_lds(LAS f32x2* Xe, LAS f32x2* Xo, const f32x2* tw, int tid, f32x2* ve, f32x2* vo) {
    constexpr int R = NPT == 16 ? 4 : 3;
    asm volatile("" : "+v"(tid)); __syncthreads();
    { LAS f32x2* Pe = Xe + PADI(tid); LAS f32x2* Po = Xo + PADI(tid);
#pragma unroll
      for (int k = 0; k < NPT; ++k) { Pe[544 * k] = ve[k]; Po[544 * k] = vo[k]; } }
    __syncthreads();
#pragma nounroll
    for (int ps = 0; ps < 3; ++ps) { int sl = pass_sl<NPT>(ps); asm volatile("" : "+s"(sl));
        const f32x2 wb = tw[(tid & ((1 << sl) - 1)) << (14 - R - sl)];
        dif_pass_rt<R>(Xe, sl, wb, tid); dif_pass_rt<R>(Xo, sl, wb, tid); __syncthreads(); }
}
template <int NPT> __device__ __forceinline__ void mid_spectrum(const LAS f32x2* X, int tid, f32x2* K, float sc) {
    if (NPT == 16) {
#pragma unroll
        for (int u = 0; u < 8; ++u) { const LAS f32x2* Xb = X + PADI(2 * tid) + 1088 * u; const f32x2 a = Xb[0], b = Xb[1]; K[2 * u] = cscale(cadd(a, b), sc); K[2 * u + 1] = cscale(csub(a, b), sc); } }
    else { f32x2 w[8]; const LAS f32x2* Xb = X + PADI(8 * tid);
#pragma unroll
        for (int k = 0; k < 8; ++k) w[k] = Xb[k];
        dif_regs<3, true>(w, (f32x2){1.f, 0.f});
#pragma unroll
        for (int k = 0; k < 8; ++k) K[k] = cscale(w[k], sc); }
}
template <int NPT> __device__ __forceinline__ void mid_mul(LAS f32x2* X, int tid, const f32x2* K) {
    if (NPT == 16) {
#pragma unroll
        for (int u = 0; u < 8; ++u) { LAS f32x2* Xb = X + PADI(2 * tid) + 1088 * u; const f32x2 a = Xb[0], b = Xb[1];
            const f32x2 s = cmul(cadd(a, b), K[2 * u]), d = cmul(csub(a, b), K[2 * u + 1]); Xb[0] = cadd(s, d); Xb[1] = csub(s, d); } }
    else { f32x2 w[8]; LAS f32x2* Xb = X + PADI(8 * tid);
#pragma unroll
        for (int k = 0; k < 8; ++k) w[k] = Xb[k];
        dif_regs<3, true>(w, (f32x2){1.f, 0.f});
#pragma unroll
        for (int k = 0; k < 8; ++k) w[k] = cmul(w[k], K[k]);
        dit_regs<3, true>(w, (f32x2){1.f, 0.f});
#pragma unroll
        for (int k = 0; k < 8; ++k) Xb[k] = w[k]; }
}
template <int NPT> __device__ __forceinline__ void conv2(LAS f32x2* Xe, LAS f32x2* Xo, const f32x2* tw, int tid, f32x2* ve, f32x2* vo, const f32x2* KE, const f32x2* KO) {
    fwd2_to_lds<NPT>(Xe, Xo, tw, tid, ve, vo);
    mid_mul<NPT>(Xe, tid, KE); mid_mul<NPT>(Xo, tid, KO);
    __syncthreads();
    constexpr int R = NPT == 16 ? 4 : 3;
#pragma nounroll
    for (int ps = 2; ps >= 0; --ps) { int sl = pass_sl<NPT>(ps); asm volatile("" : "+s"(sl));
        const f32x2 wb = tw[(tid & ((1 << sl) - 1)) << (14 - R - sl)];
        dit_pass_rt<R>(Xe, sl, wb, tid); dit_pass_rt<R>(Xo, sl, wb, tid); __syncthreads(); }
    { const LAS f32x2* Pe = Xe + PADI(tid); const LAS f32x2* Po = Xo + PADI(tid);
#pragma unroll
      for (int k = 0; k < NPT; ++k) { ve[k] = Pe[544 * k]; vo[k] = Po[544 * k]; } }
}
template <int NPT>
__device__ __forceinline__ void hyena_unit(LAS unsigned char* lds, int ch, int rowbase, int nb, const float* H2, const float* w3, const float* bias, bf16_t* ST, const f32x2* T2, int tid_in) {
    constexpr int N = 512 * NPT; int tid = tid_in; asm volatile("" : "+v"(tid));
    LAS f32x2* Xe = (LAS f32x2*)lds; LAS f32x2* Xo = (LAS f32x2*)(lds + 69632); LAS float* wsm = (LAS float*)(lds + 139264);
    __syncthreads();
    if (tid < 128) wsm[tid] = w3[(tid & 63) * 1024 + (tid >> 6) * 512 + ch];
    __syncthreads();
    LAS float* FW = (LAS float*)Xe; LAS float* BW = FW + N;
    const float dmin = -3.0701134573253945f, dmax = -15.350567286626973f;
    const float delta = fabsf(dmin + (float)ch * ((dmax - dmin) / 511.0f));
    const float bs = bias[ch];
    {
      const int lane = tid & 63, wv = tid >> 6, qs = lane & 3, rr = lane >> 2;
      float wf[16], wb[16];
#pragma unroll
      for (int s4 = 0; s4 < 4; ++s4)
#pragma unroll
          for (int e = 0; e < 4; ++e) { wf[s4 * 4 + e] = wsm[4 * (qs + 4 * s4) + e]; wb[s4 * 4 + e] = wsm[64 + 4 * (qs + 4 * s4) + e]; }
      const float tsc = -delta / (float)(N - 1);
#pragma unroll 2
      for (int it = 0; it < N / 128; ++it) { const int t = wv * (N / 8) + it * 16 + rr; const f32x4* hp = (const f32x4*)(H2 + (size_t)t * 64) + qs; float af = 0.f, ab = 0.f;
#pragma unroll
          for (int s4 = 0; s4 < 4; ++s4) { const f32x4 h = hp[4 * s4];
              af = ffma_(h.x, wf[s4 * 4], af); af = ffma_(h.y, wf[s4 * 4 + 1], af); af = ffma_(h.z, wf[s4 * 4 + 2], af); af = ffma_(h.w, wf[s4 * 4 + 3], af);
              ab = ffma_(h.x, wb[s4 * 4], ab); ab = ffma_(h.y, wb[s4 * 4 + 1], ab); ab = ffma_(h.z, wb[s4 * 4 + 2], ab); ab = ffma_(h.w, wb[s4 * 4 + 3], ab); }
          af += shfl_xor_l(af, 1, lane); ab += shfl_xor_l(ab, 1, lane); af += shfl_xor_l(af, 2, lane); ab += shfl_xor_l(ab, 2, lane);
          if (qs == 0) { const float win = expf((float)t * tsc); FW[t] = af * win + (t == 0 ? bs : 0.f); BW[t] = ab * win; } } }
    __syncthreads();
    f32x2 KE[NPT], KO[NPT];
    const f32x2* tw = T2;
    const float sc = 1.0f / (2.0f * (float)N);
    { f32x2 ve[NPT], vo[NPT];
#pragma unroll
      for (int i = 0; i < NPT; ++i) { const int j = tid + 512 * i; const float fr = FW[j], br = (j == 0) ? 0.f : BW[N - j]; const f32x2 w = T2[j * (8192 / N)]; const float d = fr - br;
          ve[i] = (f32x2){fadd_(fr, br), 0.f}; vo[i] = cscale(w, d); }
      fwd2_to_lds<NPT>(Xe, Xo, tw, tid, ve, vo);
      mid_spectrum<NPT>(Xe, tid, KE, sc); mid_spectrum<NPT>(Xo, tid, KO, sc); }
    for (int p = 0; p < nb / 2; ++p) {
        bf16_t* s0 = ST + (size_t)(rowbase + 2 * p * N) * 512 + (size_t)ch * N; bf16_t* s1 = s0 + (size_t)N * 512;
        f32x2 ve[NPT], vo[NPT];
#pragma unroll
        for (int i = 0; i < NPT; ++i) { const int j = tid + 512 * i; ve[i] = (f32x2){bf2f(s0[j]), bf2f(s1[j])}; vo[i] = cmul(ve[i], T2[j * (8192 / N)]); }
        conv2<NPT>(Xe, Xo, tw, tid, ve, vo, KE, KO);
#pragma unroll
        for (int i = 0; i < NPT; ++i) { const int j = tid + 512 * i; const f32x2 y = cadd(ve[i], cmulc(vo[i], T2[j * (8192 / N)]));
            s0[j] = (bf16_t)f2bf(y.x); s1[j] = (bf16_t)f2bf(y.y); }
    }
    __syncthreads();
}

#define XB_TMO      128
#define XB_XCNT(j)  (256  + 64 * (j))
#define XB_XSUB(j)  (1280 + 64 * (j))
#define XB_XGEN(j)  (2304 + 64 * (j))
#define XB_TOP      3328
#define XB_TOPGEN   3392
#define XCD_BAR_WORDS 3456
#define XB_SPIN_CAP (1u << 18)

__device__ __forceinline__ unsigned xb_ld(unsigned* p)              { return __hip_atomic_load(p, __ATOMIC_RELAXED, __HIP_MEMORY_SCOPE_AGENT); }
__device__ __forceinline__ unsigned xb_add(unsigned* p, unsigned v) { return __hip_atomic_fetch_add(p, v, __ATOMIC_RELAXED, __HIP_MEMORY_SCOPE_AGENT); }
__device__ __forceinline__ unsigned xb_xcc_id() { return (unsigned)__builtin_amdgcn_s_getreg((3 << 11) | 20) & 0xFu; }
#define XB_SPIN(cond, bar) do { unsigned _sp = 0; while (cond) { __builtin_amdgcn_s_sleep(1); \
    if ((++_sp & 255u) == 0u) { if (xb_ld(&(bar)[XB_TMO])) break; if (_sp > XB_SPIN_CAP) { atomicAdd(&(bar)[XB_TMO], 1u); break; } } } } while (0)

struct XcdBarrier {
    unsigned* bar; unsigned x; int w;
    volatile LAS unsigned* st;
};

__device__ __forceinline__ XcdBarrier xcd_barrier_post(unsigned* bar, volatile LAS unsigned* st) {
    XcdBarrier b; b.bar = bar; b.x = xb_xcc_id(); b.st = st; b.w = __builtin_amdgcn_readfirstlane((int)threadIdx.x >> 6);
    if (threadIdx.x == 0) (void)xb_add(&bar[XB_XCNT(b.x)], 1u);
    return b;
}
__device__ __forceinline__ void xcd_barrier_complete(unsigned* bar, unsigned x, unsigned& nloc, unsigned& nx) {
    const unsigned G = gridDim.x * gridDim.y * gridDim.z;
    unsigned sum, cnt, mine, sp = 0u;
    for (;;) {
        sum = 0u; cnt = 0u; mine = 0u;
#pragma unroll
        for (unsigned j = 0; j < 16; ++j) { const unsigned c = xb_ld(&bar[XB_XCNT(j)]); sum += c; cnt += (c > 0u) ? 1u : 0u; mine = (j == x) ? c : mine; }
        if (sum == G) break;
        __builtin_amdgcn_s_sleep(1);
        if ((++sp & 255u) == 0u) { if (xb_ld(&bar[XB_TMO])) break; if (sp > XB_SPIN_CAP) { atomicAdd(&bar[XB_TMO], 1u); break; } }
    }
    nloc = mine > 0u ? mine : 1u; nx = cnt > 0u ? cnt : 1u;
}

__device__ __forceinline__ void xcd_barrier_census(const XcdBarrier& b) {
    if (b.w == 0 && fresh_lane() == 0) { unsigned nloc, nx; xcd_barrier_complete(b.bar, b.x, nloc, nx); b.st[0] = nloc; b.st[1] = nx; }
    __syncthreads();
}
__device__ __forceinline__ void xcd_barrier(const XcdBarrier& b) {
    asm volatile("s_waitcnt vmcnt(0)" ::: "memory");
    __syncthreads();
    if (b.w == 0 && fresh_lane() == 0) {
        unsigned* bar = b.bar;
        __builtin_amdgcn_s_waitcnt(0);
        unsigned nloc = b.st[0], nx = b.st[1];
        const unsigned old = xb_add(&bar[XB_XSUB(b.x)], 1u);
        const unsigned gen = old / nloc;
        if (old + 1u == (gen + 1u) * nloc) {
            __builtin_amdgcn_fence(__ATOMIC_RELEASE, "agent");
            asm volatile("s_waitcnt vmcnt(0)" ::: "memory");
            const unsigned og = xb_add(&bar[XB_TOP], 1u);
            const unsigned tg = og / nx;
            if (og + 1u == (tg + 1u) * nx) xb_add(&bar[XB_TOPGEN], 1u);
            else XB_SPIN(xb_ld(&bar[XB_TOPGEN]) == tg, bar);
            __builtin_amdgcn_fence(__ATOMIC_ACQUIRE, "agent");
            xb_add(&bar[XB_XGEN(b.x)], 1u);
            asm volatile("s_waitcnt vmcnt(0)" ::: "memory");
        } else {
            XB_SPIN(xb_ld(&bar[XB_XGEN(b.x)]) == gen, bar);
            __builtin_amdgcn_fence(__ATOMIC_ACQUIRE, "agent");
            asm volatile("s_waitcnt vmcnt(0)" ::: "memory");
        }
    }
    __syncthreads();
}


#ifndef PROBE_SKIP
#define PROBE_SKIP 0
#endif
constexpr int NPASS = PROBE_SKIP ? 2 : 1;
#define DO(bit) (pass == NPASS - 1 || !(PROBE_SKIP & (bit)))
struct Params { const float* in[30]; float* out; unsigned char* ws; };

__global__ void __launch_bounds__(512, 2) mk_fwd(Params p) {
    extern __shared__ __attribute__((aligned(16))) unsigned char lds_raw[];
    cg::grid_group grid = cg::this_grid();
    LAS unsigned char* lds = (LAS unsigned char*)lds_raw;
    Ctx c; c.wave = __builtin_amdgcn_readfirstlane((int)threadIdx.x >> 6); c.G = gridDim.x; c.bid = blockIdx.x;
    unsigned char* ws = p.ws; float* x = p.out;
    { volatile LAS unsigned* st = (volatile LAS unsigned*)(lds + LDS_BYTES - 16); if (threadIdx.x < 4) st[threadIdx.x] = 0u; }
    __syncthreads();
    const XcdBarrier xbar = xcd_barrier_post((unsigned*)(p.ws + WS_BAR), (volatile LAS unsigned*)(lds + LDS_BYTES - 16));
#define WB ((bf16_t*)(ws + WS_W))
#define XN ((bf16_t*)(ws + WS_XN))
#define BIG ((bf16_t*)(ws + WS_BIG))
#define ST ((bf16_t*)(ws + WS_ST))
#define QH ((bf16_t*)(ws + WS_QH))
#define KVH ((bf16_t*)(ws + WS_KVH))
#define MG ((bf16_t*)(ws + WS_MG))
#define PB ((bf16_t*)(ws + WS_PB))
#define T2 ((const f32x2*)(ws + WS_T2))
#define tabA ((const f32x2*)(ws + WS_TABA))
#define tabM ((const f32x2*)(ws + WS_TABM))
#define SSQ(i) ((float*)(ws + WS_W + WO_END * 2) + (size_t)(i) * MT)
#define LAUNDER() asm volatile("" : "+s"(c.bid), "+s"(c.G), "+s"(ws), "+s"(x))
#define SYNC() do { xcd_barrier(xbar); LAUNDER(); } while (0)
#define SYNC_CG() do { grid.sync(); LAUNDER(); } while (0)
    for (int pass = 0; pass < NPASS; ++pass) {
    misc_tables(c, ws, p.in[12], p.in[13], p.in[14], p.in[15], p.in[17]);

#define GEMMX(BIT, EPI, Aptr, LDA, Bptr, NN, KK, ...) do { if (!DO(BIT)) break; pg8::Gemm g_{(const bf16_t*)(Aptr), (const bf16_t*)(Bptr), MT, NN, KK, LDA}; pg8::StaticOrder S_; S_.init(MT, NN, c.G, c.bid); \
        EPI E_{__VA_ARGS__}; pg8::gemm_phase<EPI>(lds, g_, S_, E_, c.wave); } while (0)
#define GEMM(...) GEMMX(2, __VA_ARGS__)
#define GEMMF(...) GEMMX(16, __VA_ARGS__)

    for (int l = 0; l < 2; ++l) {
        LAUNDER();
        { LayerW w; w.gate1 = p.in[3] + (size_t)l * DM * DFF; w.up1 = p.in[4] + (size_t)l * DM * DFF; w.dn1 = p.in[5] + (size_t)l * DFF * DM; w.win = p.in[7] + (size_t)l * DM * 5792;
          w.uq = p.in[20] + (size_t)l * 256 * 768; w.ukv = p.in[22] + (size_t)l * 128 * 1024; w.br = p.in[23] + (size_t)l * 3 * 512 * 1024; w.wout = p.in[24] + (size_t)l * DM * DM;
          w.gate2 = p.in[26] + (size_t)l * DM * DFF; w.up2 = p.in[27] + (size_t)l * DM * DFF; w.dn2 = p.in[28] + (size_t)l * DFF * DM;
          if (DO(8)) convert_weights(c, w, WB, lds); }
        if (l == 0 && DO(8)) norm_rows<1>(c, p.in[0], p.in[1], x, p.in[2], XN);
        if (l == 0) { SYNC_CG(); xcd_barrier_census(xbar); } else SYNC();
        const float* ssA = l == 0 ? nullptr : SSQ(0);
        float* ssMix = SSQ(0); float* ssF2 = SSQ(0);
        GEMMF(pg8::EpiSwiglu, XN, DM, WB + WO_GU1, 5632, DM, BIG, DFF, ssA);
        SYNC();
        GEMMF(pg8::EpiResid<1>, BIG, DFF, WB + WO_DN1, DM, DFF, x, p.in[6] + l * DM, XN, ssMix, (LAS float*)(lds + 131072), l == 0 ? p.in[0] : nullptr, l == 0 ? p.in[1] : nullptr);
        SYNC();
        GEMM(pg8::EpiStore, XN, DM, WB + WO_IN, ZCW, DM, BIG, ZCW, ssMix);
        SYNC();
        if (DO(8)) tok_local(c, BIG, p.in[8] + l * 64, p.in[9] + l * 64, p.in[19] + l * 256, p.in[21] + l * 128, tabA, tabM);
        if (DO(8)) hy_fwd_tiles(c, BIG, ST, p.in[10] + (size_t)l * 3 * 1536, p.in[11] + l * 1536, lds);
        SYNC();
        GEMM(pg8::EpiStore, BIG + C_CQ, ZCW, WB + WO_UQ, 768, 256, QH, 768, nullptr);
        GEMM(pg8::EpiStore, BIG + C_CKV, ZCW, WB + WO_UKV, 1024, 128, KVH, 1024, nullptr);
        __syncthreads();
        { const float* H2l = (const float*)(ws + WS_H2 + (size_t)l * 3 * MiB); const float* w3 = p.in[16] + (size_t)l * 64 * 1024; const float* hb = p.in[18] + l * 512;
          if (DO(4)) for (int u = c.bid; u < 1024; u += c.G) {
              if (u < 512) hyena_unit<16>(lds, u, 0, 8, H2l, w3, hb, ST, T2, c.wave * 64 + fresh_lane());
              else hyena_unit<8>(lds, u - 512, MP, 4, H2l + 8192 * 64, w3, hb, ST, T2, c.wave * 64 + fresh_lane()); } }
        __syncthreads();
        if (DO(1)) for (int i = 0;; ++i) { const int u = i * c.G + CTX_VCU(c); if (u >= 2560) break;
            int rowbase, qb, h, L;
            if (u < 2048) { qb = u & 31; h = (u >> 5) & 7; rowbase = (u >> 8) * LP; L = LP; } else { const int v = u - 2048; qb = v & 15; h = (v >> 4) & 7; rowbase = MP + (v >> 7) * LS; L = LS; }
            bf16_t* Qb = BIG + (size_t)(rowbase + qb * 256) * ZCW + C_Q + h * 64; const bf16_t* Kb = BIG + (size_t)rowbase * ZCW + C_K + (h >> 2) * 64; const bf16_t* Vb = BIG + (size_t)rowbase * ZCW + C_V + (h >> 2) * 64;
            att::attn_unit<4>(Qb, ZCW, Kb, ZCW, nullptr, 0, Vb, ZCW, Qb, ZCW, L, (char*)lds_raw, 0, nullptr, c.wave); }
        SYNC();
        if (DO(1)) for (int i = 0;; ++i) { const int u = i * c.G + CTX_VCU(c); if (u >= 2560) break;
            int rowbase, qb, h, L;
            if (u < 2048) { qb = u & 31; h = (u >> 5) & 7; rowbase = (u >> 8) * LP; L = LP; } else { const int v = u - 2048; qb = v & 15; h = (v >> 4) & 7; rowbase = MP + (v >> 7) * LS; L = LS; }
            const bf16_t* Qb = QH + (size_t)(rowbase + qb * 256) * 768 + h * 96; const bf16_t* K1 = KVH + (size_t)rowbase * 1024 + h * 128; const bf16_t* K2 = BIG + (size_t)rowbase * ZCW + C_KR;
            const bf16_t* Vb = K1 + 64; bf16_t* Ob = BIG + (size_t)(rowbase + qb * 256) * ZCW + C_YC + h * 64;
            att::attn_unit<6>(Qb, 768, K1, 1024, K2, ZCW, Vb, 1024, Ob, ZCW, L, (char*)lds_raw, qb * 256, tabM, c.wave); }
        if (DO(8)) hy_bwd_tiles(c, BIG, ST, p.in[10] + (size_t)l * 3 * 1536, p.in[11] + l * 1536, lds);
        SYNC();
        GEMM(pg8::EpiStore, BIG + C_Q, ZCW, WB + WO_BR, DM, 512, MG, DM, nullptr);
        GEMM(pg8::EpiGate<0>, XN, DM, WB + WO_GATE, DM, DM, MG, MG, ssMix);
        GEMM(pg8::EpiStore, BIG + C_YB, ZCW, WB + WO_BR + (size_t)1024 * 512, DM, 512, PB, DM, nullptr);
        GEMM(pg8::EpiGate<1>, XN, DM, WB + WO_GATE + (size_t)1024 * 1024, DM, DM, MG, PB, ssMix);
        GEMM(pg8::EpiStore, BIG + C_YC, ZCW, WB + WO_BR + (size_t)2 * 1024 * 512, DM, 512, PB, DM, nullptr);
        GEMM(pg8::EpiGate<1>, XN, DM, WB + WO_GATE + (size_t)2 * 1024 * 1024, DM, DM, MG, PB, ssMix);
        SYNC();
        GEMM(pg8::EpiResid<0>, MG, DM, WB + WO_OUT, DM, DM, x, p.in[25] + l * DM, XN, ssF2, (LAS float*)(lds + 131072), nullptr, nullptr);
        SYNC();
        GEMMF(pg8::EpiSwiglu, XN, DM, WB + WO_GU2, 5632, DM, BIG, DFF, ssF2);
        SYNC();
        GEMMF(pg8::EpiResid<1>, BIG, DFF, WB + WO_DN2, DM, DFF, x, l == 0 ? p.in[2] + DM : nullptr, XN, SSQ(0), (LAS float*)(lds + 131072), nullptr, nullptr);
        SYNC();
    }
    norm_rows<2>(c, nullptr, nullptr, x, p.in[29], nullptr);
    if (pass + 1 < NPASS) SYNC();
    }
}

extern "C" void kernel_launch(void* const* d_in, const int* in_sizes, int n_in, void* d_out, int out_size, void* d_ws, size_t ws_size, hipStream_t stream) {
    static int grid = 0;
    if (grid == 0) {
        if (n_in != 30 || out_size != MT * DM || ws_size < WS_END) { fprintf(stderr, "kernel_launch: unexpected shapes: n_in %d out %d ws %zu\n", n_in, out_size, ws_size); grid = -1; return; }
        int dev = 0, cus = 0, per_cu = 0;
        hipGetDevice(&dev); hipDeviceGetAttribute(&cus, hipDeviceAttributeMultiprocessorCount, dev);
        if (hipFuncSetAttribute((const void*)mk_fwd, hipFuncAttributeMaxDynamicSharedMemorySize, LDS_BYTES) != hipSuccess) { fprintf(stderr, "kernel_launch: hipFuncSetAttribute failed\n"); grid = -1; return; }
        hipOccupancyMaxActiveBlocksPerMultiprocessor(&per_cu, (const void*)mk_fwd, 512, LDS_BYTES);
        if (per_cu < 1) { fprintf(stderr, "kernel_launch: occupancy query says %d\n", per_cu); per_cu = 1; }
        (void)hipGetLastError();
        grid = cus * 1;
    }
    if (grid < 0) return;
    if (hipMemsetAsync((char*)d_ws + WS_BAR, 0, 16384, stream) != hipSuccess) { fprintf(stderr, "kernel_launch: memset failed\n"); return; }
    Params p{};
    for (int i = 0; i < 30; ++i) p.in[i] = (const float*)d_in[i];
    p.out = (float*)d_out; p.ws = (unsigned char*)d_ws;
    void* args[] = {&p};
    hipError_t e = hipLaunchCooperativeKernel((const void*)mk_fwd, dim3(grid), dim3(512), args, LDS_BYTES, stream);
    if (e != hipSuccess) fprintf(stderr, "cooperative launch failed: %s (grid %d)\n", hipGetErrorString(e), grid);
}
```

```cpp
#include <hip/hip_runtime.h>
#include <hip/hip_bf16.h>
#include <hip/hip_cooperative_groups.h>
#include <cstdio>
#include <cstdint>
namespace cg = cooperative_groups;

#define LAS __attribute__((address_space(3)))
typedef unsigned short bf16_t;
typedef short bf16x8 __attribute__((ext_vector_type(8)));
typedef short s16x4 __attribute__((ext_vector_type(4)));
typedef float f32x4 __attribute__((ext_vector_type(4)));
typedef float f32x2 __attribute__((ext_vector_type(2)));
typedef float f32x16 __attribute__((ext_vector_type(16)));
typedef unsigned u32x4 __attribute__((ext_vector_type(4)));
typedef unsigned u32x2 __attribute__((ext_vector_type(2)));

constexpr int DM = 1024, DFF = 2816, MP = 65536, MS = 16384, MT = MP + MS;
constexpr int LP = 8192, LS = 4096;
constexpr int ZCW = 2816;
constexpr int C_Q = 0, C_K = 512, C_V = 640, C_HY = 768, C_CQ = 2304, C_CKV = 2560, C_KR = 2688;
constexpr int C_YB = 1280, C_YC = 1792;
constexpr float EPS = 1e-6f;
constexpr size_t MiB = 1u << 20;
constexpr size_t WS_T2 = 0, WS_TABA = 64 * 1024, WS_TABM = 80 * 1024, WS_H2 = 1 * MiB;
constexpr size_t WS_BAR = 7 * MiB;
constexpr size_t WS_W = 8 * MiB;
constexpr size_t WS_XN = 60 * MiB;
constexpr size_t WS_BIG = 220 * MiB;
constexpr size_t WS_R2 = 660 * MiB;
constexpr size_t WS_ST = WS_R2;
constexpr size_t WS_QH = WS_R2 + 80 * MiB;
constexpr size_t WS_KVH = WS_R2 + 200 * MiB;
constexpr size_t WS_MG = WS_R2;
constexpr size_t WS_PB = WS_R2 + 160 * MiB;
constexpr size_t WS_END = 1024 * MiB;
constexpr size_t WO_GU1 = 0, WO_DN1 = WO_GU1 + 5632 * 1024, WO_IN = WO_DN1 + 1024 * 2816, WO_GATE = WO_IN + 2816 * 1024, WO_UQ = WO_GATE + 3072 * 1024,
                 WO_UKV = WO_UQ + 768 * 256, WO_BR = WO_UKV + 1024 * 128, WO_OUT = WO_BR + 3 * 1024 * 512, WO_GU2 = WO_OUT + 1024 * 1024, WO_DN2 = WO_GU2 + 5632 * 1024,
                 WO_END = WO_DN2 + 1024 * 2816;
static_assert(WO_END * 2 + 5 * (size_t)MT * 4 <= 52 * MiB, "weights + row statistics fit");
constexpr int LDS_BYTES = 139264 + 2048;

__device__ __forceinline__ int fresh_lane() { int l; asm volatile("v_mbcnt_lo_u32_b32 %0, -1, 0\n\tv_mbcnt_hi_u32_b32 %0, -1, %0" : "=v"(l)); return l; }
__device__ __forceinline__ int fresh_tid(int wave) { return wave * 64 + fresh_lane(); }
__device__ __forceinline__ float bf2f(unsigned h) { return __uint_as_float(h << 16); }
__device__ __forceinline__ unsigned f2bf(float f) { unsigned u = __float_as_uint(f); return (u + 0x7fffu + ((u >> 16) & 1u)) >> 16; }
__device__ __forceinline__ unsigned pk2(float lo, float hi) { return f2bf(lo) | (f2bf(hi) << 16); }
typedef __bf16 bf16x2_t_ __attribute__((ext_vector_type(2)));
__device__ __forceinline__ unsigned cvt_pk_bf16(float lo, float hi) { f32x2 v = {lo, hi}; bf16x2_t_ b = __builtin_convertvector(v, bf16x2_t_); return __builtin_bit_cast(unsigned, b); }
__device__ __forceinline__ float shfl_xor_l(float v, int o, int lane) { return __int_as_float(__builtin_amdgcn_ds_bpermute((lane ^ o) << 2, __float_as_int(v))); }
__device__ __forceinline__ float bcast_l(float v, int src) { return __int_as_float(__builtin_amdgcn_readlane(__float_as_int(v), src)); }
__device__ __forceinline__ float wave_sum(float v, int lane) {
#pragma unroll
    for (int o = 1; o < 64; o <<= 1) v += shfl_xor_l(v, o, lane);
    return v;
}
__device__ __forceinline__ float sigmoidf_(float x) { return __builtin_amdgcn_rcpf(1.0f + __builtin_amdgcn_exp2f(-1.4426950408889634f * x)); }

namespace pg8 {
constexpr int BM = 256, BK = 64, HALF = 128, HTB = HALF * BK * 2, STAGE_BYTES = 8 * HTB, NXCD = 8, WGM = 8;
__host__ __device__ __forceinline__ int lds_byte(int r, int c) { const int st = (r >> 4) * 2 + (c >> 5), rr = r & 15, cc = c & 31, ob = rr * 64 + cc * 2; return st * 1024 + (ob ^ (((ob >> 9) & 1) << 5)); }
__host__ __device__ __forceinline__ void stage_rc(int b, int& R, int& C) { const int st = b / 1024, sb = b % 1024, swz = sb ^ (((sb >> 9) & 1) << 5); R = (st >> 1) * 16 + swz / 64; C = (st & 1) * 32 + (swz % 64) / 2; }
__host__ __device__ __forceinline__ int perm32(int rho) { const int n = rho >> 4, i = rho & 15; return 8 * (i >> 2) + 4 * n + (i & 3); }
struct Unit { int pm, pn; };
struct Gemm { const bf16_t* A; const bf16_t* Bt; int M, N, K, lda; };
struct StaticOrder {
    int nM, nN, nwg, G, c;
    __device__ void init(int M, int N, int G_, int c_) { nM = M / BM; nN = N / BM; nwg = nM * nN; G = G_; c = c_; }
    __device__ bool next(int i, Unit& u) const {
        const long L = (long)i * G + c; if (L >= nwg) return false;
        int wgid = (int)L; { const int q = nwg / NXCD, r = nwg % NXCD, xcd = wgid % NXCD, off = wgid / NXCD; wgid = (xcd < r ? xcd * (q + 1) : r * (q + 1) + (xcd - r) * q) + off; }
        const int nig = WGM * nN, gid = wgid / nig, fm = gid * WGM, gsz = (nM - fm) < WGM ? (nM - fm) : WGM;
        u.pm = fm + ((wgid % nig) % gsz); u.pn = (wgid % nig) / gsz; return true;
    }
};
typedef f32x4 Acc[2][2][4][2];

struct EpiStore {
    bf16_t* O; int ldc; const float* ss;
    __device__ __forceinline__ void operator()(const Acc& acc, const Unit& u, int wr, int wc, int fr, int fq) const {
        const int row0 = u.pm * BM + wr * 64 + fr, col0 = u.pn * BM + wc * 32 + 8 * fq;
#pragma unroll
        for (int ai = 0; ai < 2; ++ai)
#pragma unroll
            for (int m = 0; m < 4; ++m) { const int row = row0 + ai * HALF + m * 16; bf16_t* rowp = O + (size_t)row * ldc + col0;
                const float rs = ss ? __builtin_amdgcn_rsqf(((ss[row] + ss[MT + row]) + (ss[2 * MT + row] + ss[3 * MT + row])) * (1.f / DM) + EPS) : 1.f;
#pragma unroll
                for (int bj = 0; bj < 2; ++bj) { const f32x4 v0 = acc[ai][bj][m][0] * rs, v1 = acc[ai][bj][m][1] * rs;
                    u32x4 w; w.x = cvt_pk_bf16(v0[0], v0[1]); w.y = cvt_pk_bf16(v0[2], v0[3]); w.z = cvt_pk_bf16(v1[0], v1[1]); w.w = cvt_pk_bf16(v1[2], v1[3]);
                    *(u32x4*)(rowp + bj * HALF) = w; } }
    }
};
struct EpiSwiglu {
    bf16_t* O; int ldc; const float* ss;
    __device__ __forceinline__ void operator()(const Acc& acc, const Unit& u, int wr, int wc, int fr, int fq) const {
        const int row0 = u.pm * BM + wr * 64 + fr, col0 = u.pn * HALF + wc * 32 + 8 * fq;
#pragma unroll
        for (int ai = 0; ai < 2; ++ai)
#pragma unroll
            for (int m = 0; m < 4; ++m) { const int row = row0 + ai * HALF + m * 16; bf16_t* rowp = O + (size_t)row * ldc + col0;
                const float rs = ss ? __builtin_amdgcn_rsqf(((ss[row] + ss[MT + row]) + (ss[2 * MT + row] + ss[3 * MT + row])) * (1.f / DM) + EPS) : 1.f;
                float h[8];
#pragma unroll
                for (int n = 0; n < 2; ++n)
#pragma unroll
                    for (int j = 0; j < 4; ++j) { const float g = acc[ai][0][m][n][j] * rs, up = acc[ai][1][m][n][j] * rs; h[n * 4 + j] = g * sigmoidf_(g) * up; }
                u32x4 w; w.x = cvt_pk_bf16(h[0], h[1]); w.y = cvt_pk_bf16(h[2], h[3]); w.z = cvt_pk_bf16(h[4], h[5]); w.w = cvt_pk_bf16(h[6], h[7]);
                *(u32x4*)rowp = w; }
    }
};
template <int HALFA> struct EpiResid {
    float* X_; const float* gnext_; bf16_t* XNo_; float* ss_; LAS float* part_; const float* Rp_; const float* Rs_;
    __device__ __forceinline__ void operator()(const Acc& acc, const Unit& u, int wr, int wc, int fr, int fq) const {
        float* const X = X_; const float alpha = HALFA ? 0.5f : 1.0f; const float* const gnext = gnext_; bf16_t* const XNo = XNo_; float* const ss = ss_; LAS float* const part = part_;
        const float* const R = Rp_ ? (u.pm * BM < MP ? Rp_ : Rs_ - (size_t)MP * DM) : X;
        const int row0 = u.pm * BM + wr * 64 + fr, col0 = u.pn * BM + wc * 32 + 8 * fq; const int lane = fr + 16 * fq;
        f32x4 gv[2][2];
        if (gnext) {
#pragma unroll
            for (int bj = 0; bj < 2; ++bj)
#pragma unroll
                for (int n = 0; n < 2; ++n) gv[bj][n] = *(const f32x4*)(gnext + col0 + bj * HALF + 4 * n); }
#pragma unroll
        for (int ai = 0; ai < 2; ++ai)
#pragma unroll
            for (int m = 0; m < 4; ++m) { const int row = row0 + ai * HALF + m * 16; float* rowp = X + (size_t)row * DM + col0; float sq = 0.f;
#pragma unroll
                for (int bj = 0; bj < 2; ++bj) { f32x4* p0 = (f32x4*)(rowp + bj * HALF); const f32x4* r0 = (const f32x4*)(R + (size_t)row * DM + col0 + bj * HALF); const f32x4 o0 = r0[0] + acc[ai][bj][m][0] * alpha, o1 = r0[1] + acc[ai][bj][m][1] * alpha; p0[0] = o0; p0[1] = o1;
                    if (gnext) { sq += (o0[0] * o0[0] + o0[1] * o0[1]) + (o0[2] * o0[2] + o0[3] * o0[3]) + (o1[0] * o1[0] + o1[1] * o1[1]) + (o1[2] * o1[2] + o1[3] * o1[3]);
                        const f32x4 y0 = o0 * gv[bj][0], y1 = o1 * gv[bj][1];
                        u32x4 w; w.x = cvt_pk_bf16(y0[0], y0[1]); w.y = cvt_pk_bf16(y0[2], y0[3]); w.z = cvt_pk_bf16(y1[0], y1[1]); w.w = cvt_pk_bf16(y1[2], y1[3]);
                        *(u32x4*)(XNo + (size_t)row * DM + col0 + bj * HALF) = w; } }
                if (gnext) { sq += shfl_xor_l(sq, 16, lane); sq += shfl_xor_l(sq, 32, lane); if (fq == 0) part[wc * 256 + ai * HALF + wr * 64 + m * 16 + fr] = sq; }
                asm volatile("" ::: "memory"); }
        if (gnext) {
            asm volatile("s_waitcnt lgkmcnt(0)" ::: "memory"); __builtin_amdgcn_s_barrier(); asm volatile("" ::: "memory");
            const int t = (wr * 4 + wc) * 64 + lane;
            if (t < 256) ss[(size_t)u.pn * MT + u.pm * BM + t] = (part[t] + part[256 + t]) + (part[512 + t] + part[768 + t]);
        }
    }
};
template <int ACCUM> struct EpiGate {
    bf16_t* MG; const bf16_t* PB; const float* ss;
    __device__ __forceinline__ void operator()(const Acc& acc, const Unit& u, int wr, int wc, int fr, int fq) const {
        const int row0 = u.pm * BM + wr * 64 + fr, col0 = u.pn * BM + wc * 32 + 8 * fq;
#pragma unroll
        for (int ai = 0; ai < 2; ++ai)
#pragma unroll
            for (int m = 0; m < 4; ++m) { const int row = row0 + ai * HALF + m * 16; const size_t ro = (size_t)row * DM + col0; const float rs = __builtin_amdgcn_rsqf(((ss[row] + ss[MT + row]) + (ss[2 * MT + row] + ss[3 * MT + row])) * (1.f / DM) + EPS);
#pragma unroll
                for (int bj = 0; bj < 2; ++bj) { const u32x4 pb = *(const u32x4*)(PB + ro + bj * HALF); u32x4 old = {0u, 0u, 0u, 0u};
                    if (ACCUM) old = *(const u32x4*)(MG + ro + bj * HALF);
                    float r[8];
#pragma unroll
                    for (int e = 0; e < 8; ++e) { const float a = acc[ai][bj][m][e >> 2][e & 3] * rs; const unsigned pw = pb[e >> 1], ow = old[e >> 1];
                        const float pv = (e & 1) ? __uint_as_float(pw & 0xffff0000u) : __uint_as_float(pw << 16);
                        const float ov = (e & 1) ? __uint_as_float(ow & 0xffff0000u) : __uint_as_float(ow << 16);
                        r[e] = sigmoidf_(a) * pv + (ACCUM ? ov : 0.f); }
                    u32x4 w; w.x = cvt_pk_bf16(r[0], r[1]); w.y = cvt_pk_bf16(r[2], r[3]); w.z = cvt_pk_bf16(r[4], r[5]); w.w = cvt_pk_bf16(r[6], r[7]);
                    *(u32x4*)(MG + ro + bj * HALF) = w; } }
    }
};

__device__ __forceinline__ void glds16_s(const void* sbase, unsigned voff, unsigned lds_dst) {
    asm volatile("s_mov_b32 m0, %2\n\ts_nop 0\n\tglobal_load_lds_dwordx4 %0, %1" :: "v"(voff), "s"(sbase), "s"(lds_dst) : "memory", "m0"); }
template <class Epi>
__device__ __forceinline__ void gemm_phase(LAS unsigned char* lds, const Gemm g, const StaticOrder& S, const Epi& E, int wave) {
    const int tid = fresh_tid(wave), wid = wave, lane = tid & 63, wr = wid >> 2, wc = wid & 3, fr = lane & 15, fq = lane >> 4;
    const int K = g.K, nt = K / BK, lda = g.lda;
    unsigned voffA[2], voffB[2];
#pragma unroll
    for (int i = 0; i < 2; ++i) { int R, C; stage_rc(tid * 16 + i * 8192, R, C); const int Rb = (R & ~31) + perm32(R & 31);
        voffA[i] = (unsigned)(R * lda + C) * 2u; voffB[i] = (unsigned)(Rb * K + C) * 2u; }
    const size_t kstep = (size_t)(BK * 2);
    const size_t hstepA = (size_t)HALF * lda * 2, hstepB = (size_t)HALF * K * 2;
    const size_t tstepA = 2 * hstepA, tstepB = 2 * hstepB;
    const unsigned ldsw = (unsigned)wid * 1024u; const unsigned lds0 = (unsigned)(__UINTPTR_TYPE__)lds;
    const int aoff = lds_byte(wr * 64 + fr, fq * 8), boff = lds_byte(wc * 32 + fr, fq * 8);
#define PG8_SA(b, h) (((b) * 2 + (h)) * HTB)
#define PG8_SB(b, h) ((4 + (b) * 2 + (h)) * HTB)
#define PG8_STAGE(bufoff, gbase, voff) do { _Pragma("unroll") for (int _i = 0; _i < 2; ++_i) \
        glds16_s((const void*)(gbase), (voff)[_i], lds0 + (unsigned)((bufoff) + _i * 8192) + ldsw); } while (0)
#define PG8_LDA(dst, b, h) do { _Pragma("unroll") for (int m = 0; m < 4; ++m) _Pragma("unroll") for (int k = 0; k < 2; ++k) dst[m][k] = *(const LAS bf16x8*)(lds + PG8_SA(b, h) + aoff + m * 2048 + k * 1024); } while (0)
#define PG8_LDB(dst, b, h) do { _Pragma("unroll") for (int n = 0; n < 2; ++n) _Pragma("unroll") for (int k = 0; k < 2; ++k) dst[n][k] = *(const LAS bf16x8*)(lds + PG8_SB(b, h) + boff + n * 2048 + k * 1024); } while (0)
#define PG8_MMA(ai, bj, At, Bt) do { __builtin_amdgcn_s_setprio(1); _Pragma("unroll") for (int m = 0; m < 4; ++m) _Pragma("unroll") for (int n = 0; n < 2; ++n) _Pragma("unroll") for (int k = 0; k < 2; ++k) \
        acc[ai][bj][m][n] = __builtin_amdgcn_mfma_f32_16x16x32_bf16(Bt[n][k], At[m][k], acc[ai][bj][m][n], 0, 0, 0); __builtin_amdgcn_s_setprio(0); } while (0)
#define PG8_WAIT_V(n) asm volatile("s_waitcnt vmcnt(" #n ")" ::: "memory")
#define PG8_WAIT_L(n) asm volatile("s_waitcnt lgkmcnt(" #n ")" ::: "memory")
#define PG8_BAR __builtin_amdgcn_s_barrier()
#define PG8_SCHED __builtin_amdgcn_sched_barrier(0)
    Unit cur, nxt; int ui = 0;
    if (!S.next(0, cur)) return;
    float zf = 0.f; asm volatile("" : "+v"(zf));
    Acc acc;
#pragma unroll
    for (int a = 0; a < 2; ++a)
#pragma unroll
        for (int b = 0; b < 2; ++b)
#pragma unroll
            for (int m = 0; m < 4; ++m)
#pragma unroll
                for (int n = 0; n < 2; ++n) acc[a][b][m][n] = (f32x4){zf, zf, zf, zf};
    bf16x8 At[4][2], B0[2][2], B1[2][2];
    const char* cA = (const char*)g.A + (size_t)cur.pm * tstepA; const char* cB = (const char*)g.Bt + (size_t)cur.pn * tstepB;
    PG8_STAGE(PG8_SB(0, 0), cB, voffB); PG8_STAGE(PG8_SB(0, 1), cB + hstepB, voffB); PG8_STAGE(PG8_SA(0, 0), cA, voffA); PG8_STAGE(PG8_SA(0, 1), cA + hstepA, voffA);
    if (wr == 1) PG8_BAR;
    PG8_WAIT_V(2); PG8_BAR;
    PG8_STAGE(PG8_SB(1, 0), cB + kstep, voffB); PG8_STAGE(PG8_SA(1, 0), cA + kstep, voffA); PG8_STAGE(PG8_SB(1, 1), cB + hstepB + kstep, voffB);
    PG8_WAIT_V(6); PG8_BAR;
    for (;;) {
        const bool has_next = S.next(ui + 1, nxt);
        const char* nA = has_next ? (const char*)g.A + (size_t)nxt.pm * tstepA : cA; const char* nB = has_next ? (const char*)g.Bt + (size_t)nxt.pn * tstepB : cB;
        for (int t = 0; t < nt; t += 2) {
            const bool last = (t == nt - 2);
            const char* a1 = cA + (size_t)(t + 1) * kstep;
            const char* a2 = last ? nA : cA + (size_t)(t + 2) * kstep; const char* b2 = last ? nB : cB + (size_t)(t + 2) * kstep;
            const char* a3 = a2 + kstep; const char* b3 = b2 + kstep;
            PG8_LDB(B0, 0, 0); PG8_LDB(B1, 0, 1); PG8_SCHED; PG8_LDA(At, 0, 0); PG8_STAGE(PG8_SA(1, 1), a1 + hstepA, voffA);
            PG8_WAIT_V(8); PG8_WAIT_L(0); PG8_BAR; PG8_MMA(0, 0, At, B0); PG8_MMA(0, 1, At, B1); PG8_BAR; PG8_SCHED;
            PG8_LDA(At, 0, 1); PG8_STAGE(PG8_SB(0, 0), b2, voffB); PG8_STAGE(PG8_SB(0, 1), b2 + hstepB, voffB); PG8_STAGE(PG8_SA(0, 0), a2, voffA);
            PG8_WAIT_V(8); PG8_WAIT_L(0); PG8_BAR; PG8_MMA(1, 0, At, B0); PG8_MMA(1, 1, At, B1); PG8_BAR; PG8_SCHED;
            PG8_LDB(B0, 1, 0); PG8_LDB(B1, 1, 1); PG8_SCHED; PG8_LDA(At, 1, 0); PG8_STAGE(PG8_SA(0, 1), a2 + hstepA, voffA);
            PG8_WAIT_V(8); PG8_WAIT_L(0); PG8_BAR; PG8_MMA(0, 0, At, B0); PG8_MMA(0, 1, At, B1); PG8_BAR; PG8_SCHED;
            PG8_LDA(At, 1, 1); PG8_STAGE(PG8_SB(1, 0), b3, voffB); PG8_STAGE(PG8_SB(1, 1), b3 + hstepB, voffB); PG8_STAGE(PG8_SA(1, 0), a3, voffA);
            PG8_WAIT_V(8); PG8_WAIT_L(0); PG8_BAR; PG8_MMA(1, 0, At, B0); PG8_MMA(1, 1, At, B1); PG8_BAR; PG8_SCHED;
        }
        if (wr == 0) PG8_BAR;
        { const int l2 = fresh_lane(); E(acc, cur, wr, wc, l2 & 15, l2 >> 4); }
        if (!has_next) break;
#pragma unroll
        for (int a = 0; a < 2; ++a)
#pragma unroll
            for (int b = 0; b < 2; ++b)
#pragma unroll
                for (int m = 0; m < 4; ++m)
#pragma unroll
                    for (int n = 0; n < 2; ++n) acc[a][b][m][n] = (f32x4){zf, zf, zf, zf};
        cur = nxt; cA = nA; cB = nB; ++ui;
        if (wr == 1) PG8_BAR;
    }
    PG8_WAIT_V(0);
    PG8_BAR;
#undef PG8_SA
#undef PG8_SB
#undef PG8_STAGE
#undef PG8_LDA
#undef PG8_LDB
#undef PG8_MMA
#undef PG8_WAIT_V
#undef PG8_WAIT_L
#undef PG8_BAR
#undef PG8_SCHED
}
}

namespace att {
typedef __bf16 bf16x2_t __attribute__((ext_vector_type(2)));
__device__ __forceinline__ unsigned cvtpk_s(float lo, float hi) { f32x2 v = {lo, hi}; bf16x2_t b = __builtin_convertvector(v, bf16x2_t); return __builtin_bit_cast(unsigned, b); }
constexpr int NW = 8, QBLK = 32, KVBLK = 64;
constexpr float THR = 8.f;
constexpr int SHM_V = 16384, SHM_K = 16384;
#define KSWZ(row, colB) ((row) * 256 + ((colB) ^ (((row) & 7) << 4)))
#define SBAR() __builtin_amdgcn_sched_barrier(0)
__device__ __forceinline__ int crow(int r, int hi) { return (r & 3) + 8 * (r >> 2) + 4 * hi; }
template <int DKB> struct Sc { static constexpr float SCALE = DKB == 4 ? 0.125f : 0.10206207261596575f; };

constexpr float THR2 = 11.5f;
__device__ __forceinline__ float rowmax32(const f32x16& p0, const f32x16& p1) {
  float pmax = p0[0];
#pragma unroll
  for (int r = 1; r < 16; ++r) pmax = fmaxf(pmax, p0[r]);
#pragma unroll
  for (int r = 0; r < 16; ++r) pmax = fmaxf(pmax, p1[r]);
  auto rr = __builtin_amdgcn_permlane32_swap(__float_as_uint(pmax), __float_as_uint(pmax), false, false);
  return fmaxf(__uint_as_float(rr[0]), __uint_as_float(rr[1]));
}
template <bool FIRST> __device__ __forceinline__ void partialSM(f32x16& p0, f32x16& p1, float& m_reg, f32x16& negm, float& alpha) {
  const float pmax = rowmax32(p0, p1);
  alpha = 1.f;
  if (FIRST) { m_reg = pmax; p0 = p0 - pmax; p1 = p1 - pmax;
#pragma unroll
    for (int r = 0; r < 16; ++r) negm[r] = -m_reg; }
  else if (__builtin_expect(!__all(pmax <= THR2), 0)) { const float dl = fmaxf(pmax, 0.f); m_reg += dl; p0 = p0 - dl; p1 = p1 - dl; alpha = __builtin_amdgcn_exp2f(-dl);
#pragma unroll
    for (int r = 0; r < 16; ++r) negm[r] = -m_reg; }
#pragma unroll
  for (int r = 0; r < 16; ++r) p0[r] = __builtin_amdgcn_exp2f(p0[r]);
}
__device__ __forceinline__ void finishSM(f32x16& p0, f32x16& p1, bf16x8& pa0, bf16x8& pa1, bf16x8& pa2, bf16x8& pa3) {
#pragma unroll
  for (int r = 0; r < 16; ++r) p1[r] = __builtin_amdgcn_exp2f(p1[r]);
#define PK4(P, BASE, OUT) do { unsigned a0 = cvtpk_s(P[BASE + 0], P[BASE + 1]), a1 = cvtpk_s(P[BASE + 2], P[BASE + 3]);   \
    unsigned b0 = cvtpk_s(P[BASE + 4], P[BASE + 5]), b1 = cvtpk_s(P[BASE + 6], P[BASE + 7]);                              \
    auto r0 = __builtin_amdgcn_permlane32_swap(a0, b0, false, false); auto r1 = __builtin_amdgcn_permlane32_swap(a1, b1, false, false); \
    u32x4 w = {r0[0], r1[0], r0[1], r1[1]}; OUT = *reinterpret_cast<bf16x8*>(&w); } while (0)
  PK4(p0, 0, pa0); PK4(p0, 8, pa1); PK4(p1, 0, pa2); PK4(p1, 8, pa3);
#undef PK4
}
template <int DKB> __device__ __forceinline__ void qkt(f32x16& p0, f32x16& p1, const char* Ks, const bf16x8* qr, const f32x16& negm, int r32, int hi) {
#pragma unroll
  for (int d0 = 0; d0 < DKB; ++d0) { int cb = (d0 * 16 + hi * 8) * 2;
    bf16x8 b0 = *reinterpret_cast<const bf16x8*>(Ks + KSWZ(r32, cb));
    bf16x8 b1 = *reinterpret_cast<const bf16x8*>(Ks + KSWZ(32 + r32, cb));
    if (d0 == 0) { p0 = __builtin_amdgcn_mfma_f32_32x32x16_bf16(b0, qr[0], negm, 0, 0, 0); p1 = __builtin_amdgcn_mfma_f32_32x32x16_bf16(b1, qr[0], negm, 0, 0, 0); }
    else { p0 = __builtin_amdgcn_mfma_f32_32x32x16_bf16(b0, qr[d0], p0, 0, 0, 0); p1 = __builtin_amdgcn_mfma_f32_32x32x16_bf16(b1, qr[d0], p1, 0, 0, 0); } }
}
__device__ __forceinline__ int v_st(int k, int c) { const int kk = (k & ~0xC) | ((k & 4) << 1) | ((k & 8) >> 1); return ((kk >> 3) * 4 + (c >> 5)) * 512 + ((kk & 7) * 32 + (c & 31)) * 2; }
__device__ __forceinline__ int v_rd_base(int lane) { return ((lane & 3) << 3) | (((lane >> 2) & 3) << 6) | (((lane >> 4) & 1) << 5) | (((lane >> 5) & 1) << 8); }
constexpr int v_rd_off(int d0, int ks, int half) { return d0 * 512 + ks * 4096 + half * 2048; }
template <int OFF> __device__ __forceinline__ s16x4 tr_read(int vb) {
  s16x4 r; asm volatile("ds_read_b64_tr_b16 %0, %1 offset:%2" : "=&v"(r) : "v"(vb), "i"(OFF) : "memory"); return r;
}
template <int D0> __device__ __forceinline__ void pv_one(f32x16& od, int vb, bf16x8 pa0, bf16x8 pa1, bf16x8 pa2, bf16x8 pa3) {
  const s16x4 l0 = tr_read<v_rd_off(D0, 0, 0)>(vb), h0 = tr_read<v_rd_off(D0, 0, 1)>(vb), l1 = tr_read<v_rd_off(D0, 1, 0)>(vb), h1 = tr_read<v_rd_off(D0, 1, 1)>(vb);
  const s16x4 l2 = tr_read<v_rd_off(D0, 2, 0)>(vb), h2 = tr_read<v_rd_off(D0, 2, 1)>(vb), l3 = tr_read<v_rd_off(D0, 3, 0)>(vb), h3 = tr_read<v_rd_off(D0, 3, 1)>(vb);
  asm volatile("s_waitcnt lgkmcnt(0)" ::: "memory"); SBAR();
#define PK(L, H) (bf16x8){L[0], L[1], L[2], L[3], H[0], H[1], H[2], H[3]}
  od = __builtin_amdgcn_mfma_f32_32x32x16_bf16(pa0, PK(l0, h0), od, 0, 0, 0);
  od = __builtin_amdgcn_mfma_f32_32x32x16_bf16(pa1, PK(l1, h1), od, 0, 0, 0);
  od = __builtin_amdgcn_mfma_f32_32x32x16_bf16(pa2, PK(l2, h2), od, 0, 0, 0);
  od = __builtin_amdgcn_mfma_f32_32x32x16_bf16(pa3, PK(l3, h3), od, 0, 0, 0);
#undef PK
}
__device__ __forceinline__ void pv_d0(f32x16* o, int vb, bf16x8 pa0, bf16x8 pa1, bf16x8 pa2, bf16x8 pa3) {
  const bf16x8 ones = {16256, 16256, 16256, 16256, 16256, 16256, 16256, 16256};
  pv_one<0>(o[0], vb, pa0, pa1, pa2, pa3);
  o[2] = __builtin_amdgcn_mfma_f32_32x32x16_bf16(pa0, ones, o[2], 0, 0, 0); o[2] = __builtin_amdgcn_mfma_f32_32x32x16_bf16(pa1, ones, o[2], 0, 0, 0);
  pv_one<1>(o[1], vb, pa0, pa1, pa2, pa3);
  o[2] = __builtin_amdgcn_mfma_f32_32x32x16_bf16(pa2, ones, o[2], 0, 0, 0); o[2] = __builtin_amdgcn_mfma_f32_32x32x16_bf16(pa3, ones, o[2], 0, 0, 0);
}
template <int DKB>
__device__ __forceinline__ void attn_unit(const bf16_t* Qb, int ldq, const bf16_t* K1, int ldk1, const bf16_t* K2, int ldk2, const bf16_t* Vh, int ldv, bf16_t* Ob, int ldo, int seq, char* lds, int tq0, const f32x2* tab, int wave) {
  const int tid = fresh_tid(wave), wid = wave, lane = tid & 63, r32 = lane & 31, hi = lane >> 5;
  char* V_lds = lds; char* K_lds = lds + 3 * SHM_V;
  float* ws = (float*)(lds + 3 * SHM_V + 3 * SHM_K) + wid * 64; float* al_l = ws + 32;
  float m_reg = 0.f; f32x16 o[3] = {}; bf16x8 qr[DKB]; f32x16 negm = {};
  constexpr float QC = Sc<DKB>::SCALE * 1.4426950408889634f;
  const bf16_t* Qw = Qb + (long)(wid * QBLK + r32) * ldq + hi * 8;
#pragma unroll
  for (int d0 = 0; d0 < DKB; ++d0) { u32x4 w = *reinterpret_cast<const u32x4*>(Qw + d0 * 16);
    if (DKB == 6 && d0 >= 4) {
      const int tq = tq0 + wid * QBLK + r32; const f32x2* tb = tab + (d0 == 4 ? (tq >> 6) : (tq & 63)) * 8 + hi * 4;
#pragma unroll
      for (int e = 0; e < 4; ++e) { const f32x2 cs = tb[e]; const float x0 = __uint_as_float(w[e] << 16), x1 = __uint_as_float(w[e] & 0xffff0000u);
        w[e] = cvt_pk_bf16((x0 * cs.x - x1 * cs.y) * QC, (x0 * cs.y + x1 * cs.x) * QC); }
    } else {
#pragma unroll
      for (int e = 0; e < 4; ++e) w[e] = cvt_pk_bf16(__uint_as_float(w[e] << 16) * QC, __uint_as_float(w[e] & 0xffff0000u) * QC); }
    qr[d0] = *reinterpret_cast<bf16x8*>(&w); }
  const int sr = tid >> 3, sc = (tid & 7) * 8, vst0 = v_st(sr, sc), kst0 = KSWZ(sr, sc * 2);
  const int sr2 = (tid & 255) >> 2, sc2 = (tid & 3) * 8, kst2 = KSWZ(sr2, (64 + sc2) * 2);
  const int vb0 = (int)(uintptr_t)V_lds + v_rd_base(lane);
  struct { bf16x8 vs, ks, k2; } sr_[2];
#define SLOAD(i, k0) do { sr_[i].vs = *reinterpret_cast<const bf16x8*>(&Vh[(long)((k0) + sr) * ldv + sc]); sr_[i].ks = *reinterpret_cast<const bf16x8*>(&K1[(long)((k0) + sr) * ldk1 + sc]); \
    if (DKB == 6) sr_[i].k2 = *reinterpret_cast<const bf16x8*>(&K2[(long)((k0) + sr2) * ldk2 + sc2]); } while (0)
#define SWRITE(off, i) do { *(bf16x8*)(V_lds + (off) + vst0) = sr_[i].vs; *(bf16x8*)(K_lds + (off) + kst0) = sr_[i].ks; \
    if (DKB == 6) *(bf16x8*)(K_lds + (off) + kst2) = sr_[i].k2; } while (0)
#define SWAIT() do { if (DKB == 6) asm volatile("s_waitcnt vmcnt(3)" ::: "memory"); else asm volatile("s_waitcnt vmcnt(2)" ::: "memory"); } while (0)
#define RESC(a) do { if (__any((a) < 1.f)) { if (hi == 0) al_l[r32] = (a); asm volatile("s_waitcnt lgkmcnt(0)" ::: "memory"); \
    _Pragma("unroll") for (int d = 0; d < 3; ++d) _Pragma("unroll") for (int r = 0; r < 16; ++r) o[d][r] *= al_l[crow(r, hi)]; } } while (0)
#define ROT() do { o_prev = o_cur; o_cur = o_next; o_next = (o_next == 2 * SLOT) ? 0 : o_next + SLOT; } while (0)
  constexpr int SLOT = 16384;
  f32x16 pA0, pA1, pB0, pB1; float alA, alB; bf16x8 pa0, pa1, pa2, pa3; const int NT = seq / KVBLK;
  constexpr int SE = 0, SO = 1;
  int o_prev = 0, o_cur = 0, o_next = SLOT;
  SLOAD(SE, 0); asm volatile("s_waitcnt vmcnt(0)" ::: "memory"); SWRITE(0, SE); __syncthreads();
  qkt<DKB>(pA0, pA1, K_lds, qr, negm, r32, hi); partialSM<true>(pA0, pA1, m_reg, negm, alA);
  SLOAD(SO, KVBLK); if (2 < NT) SLOAD(SE, 2 * KVBLK);
  SWAIT(); SWRITE(SLOT, SO); __syncthreads();
  ROT();
  for (int j = 1; j + 1 < NT; j += 2) {
    SBAR(); qkt<DKB>(pB0, pB1, K_lds + o_cur, qr, negm, r32, hi);
    finishSM(pA0, pA1, pa0, pa1, pa2, pa3); SBAR();
    SLOAD(SO, (j + 2) * KVBLK); SBAR();
    pv_d0(o, vb0 + o_prev, pa0, pa1, pa2, pa3); partialSM<false>(pB0, pB1, m_reg, negm, alB);
    SWAIT(); SWRITE(o_next, SE);
    RESC(alB); __syncthreads(); ROT();
    SBAR(); qkt<DKB>(pA0, pA1, K_lds + o_cur, qr, negm, r32, hi);
    finishSM(pB0, pB1, pa0, pa1, pa2, pa3); SBAR();
    if (j + 3 < NT) SLOAD(SE, (j + 3) * KVBLK); SBAR();
    pv_d0(o, vb0 + o_prev, pa0, pa1, pa2, pa3); partialSM<false>(pA0, pA1, m_reg, negm, alA);
    SWAIT(); SWRITE(o_next, SO);
    RESC(alA); __syncthreads(); ROT();
  }
  SBAR(); qkt<DKB>(pB0, pB1, K_lds + o_cur, qr, negm, r32, hi);
  finishSM(pA0, pA1, pa0, pa1, pa2, pa3); SBAR();
  pv_d0(o, vb0 + o_prev, pa0, pa1, pa2, pa3); partialSM<false>(pB0, pB1, m_reg, negm, alB);
  RESC(alB);
  finishSM(pB0, pB1, pa0, pa1, pa2, pa3); SBAR();
  pv_d0(o, vb0 + o_cur, pa0, pa1, pa2, pa3);
  float rli[16];
#pragma unroll
  for (int r = 0; r < 16; ++r) rli[r] = __builtin_amdgcn_rcpf(o[2][r]);
  bf16_t* Ow = Ob + (long)(wid * QBLK) * ldo;
#pragma unroll
  for (int r = 0; r < 16; ++r) { int orow = crow(r, hi);
#pragma unroll
    for (int d0 = 0; d0 < 2; ++d0) Ow[(long)orow * ldo + d0 * 32 + r32] = (bf16_t)f2bf(o[d0][r] * rli[r]); }
  __syncthreads();
#undef SLOAD
#undef SWRITE
#undef SWAIT
#undef RESC
#undef ROT
}
#undef SBAR
}

struct Ctx { int wave, G, bid; };
#define CTX_GW(c) ((c).bid * 8 + (c).wave)
#define CTX_NGW(c) ((c).G * 8)
#define CTX_VCU(c) (((c).G % 8 == 0) ? ((c).bid % 8) * ((c).G / 8) + (c).bid / 8 : (c).bid)
#define LOCAL_TID const int tid = c.wave * 64 + fresh_lane(); const int lane = tid & 63; (void)lane;

__device__ __forceinline__ void tr_item(const float* W, int ldw, int Kd, int k0, int n0, bf16_t* WT, int drow0, LAS float* scr, int lane) {
#pragma unroll 8
    for (int i = 0; i < 32; ++i) { const int kk = 2 * i + (lane >> 5); scr[kk * 33 + (lane & 31)] = W[(size_t)(k0 + kk) * ldw + n0 + (lane & 31)]; }
    asm volatile("s_waitcnt lgkmcnt(0)" ::: "memory");
    const int c = lane & 7;
#pragma unroll
    for (int j = 0; j < 4; ++j) { const int n = (lane >> 3) + 8 * j; const LAS float* s = scr + (8 * c) * 33 + n;
        u32x4 o; o.x = pk2(s[0 * 33], s[1 * 33]); o.y = pk2(s[2 * 33], s[3 * 33]); o.z = pk2(s[4 * 33], s[5 * 33]); o.w = pk2(s[6 * 33], s[7 * 33]);
        *(u32x4*)(WT + (size_t)(drow0 + n) * Kd + k0 + 8 * c) = o; }
    asm volatile("s_waitcnt lgkmcnt(0)" ::: "memory");
}
struct LayerW { const float *gate1, *up1, *dn1, *win, *uq, *ukv, *br, *wout, *gate2, *up2, *dn2; };
__device__ __forceinline__ void convert_weights(const Ctx& c, const LayerW& w, bf16_t* WB, LAS unsigned char* lds) {
    LOCAL_TID
    LAS float* scr = (LAS float*)(lds + c.wave * 16384);
    constexpr int I_G = 16 * 88, I_D = 44 * 32, I_IN = 16 * 85, I_GT = 16 * 96, I_UQ = 4 * 24, I_UKV = 2 * 32, I_BR = 8 * 32, I_OUT = 16 * 32;
    constexpr int NITEMS = 4 * I_G + 2 * I_D + I_IN + I_GT + I_UQ + I_UKV + 3 * I_BR + I_OUT;
    for (int it = CTX_GW(c); it < NITEMS; it += CTX_NGW(c)) {
        int r = it;
#define FFN_GU(src, dst, upofs) { const int kb = r / 88, nb = r % 88, n0 = nb * 32; tr_item(src, DFF, DM, kb * 64, n0, dst, (n0 >> 7) * 256 + (upofs) + (n0 & 127), scr, lane); }
        if (r < I_G) { FFN_GU(w.gate1, WB + WO_GU1, 0); continue; } r -= I_G;
        if (r < I_G) { FFN_GU(w.up1, WB + WO_GU1, 128); continue; } r -= I_G;
        if (r < I_G) { FFN_GU(w.gate2, WB + WO_GU2, 0); continue; } r -= I_G;
        if (r < I_G) { FFN_GU(w.up2, WB + WO_GU2, 128); continue; } r -= I_G;
#undef FFN_GU
        if (r < I_D) { const int kb = r / 32, nb = r % 32; tr_item(w.dn1, DM, DFF, kb * 64, nb * 32, WB + WO_DN1, nb * 32, scr, lane); continue; } r -= I_D;
        if (r < I_D) { const int kb = r / 32, nb = r % 32; tr_item(w.dn2, DM, DFF, kb * 64, nb * 32, WB + WO_DN2, nb * 32, scr, lane); continue; } r -= I_D;
        if (r < I_IN) { const int kb = r / 85, nb = r % 85; tr_item(w.win, 5792, DM, kb * 64, nb * 32, WB + WO_IN, nb * 32, scr, lane); continue; } r -= I_IN;
        if (r < I_GT) { const int kb = r / 96, nb = r % 96; tr_item(w.win, 5792, DM, kb * 64, 2720 + nb * 32, WB + WO_GATE, nb * 32, scr, lane); continue; } r -= I_GT;
        if (r < I_UQ) { const int kb = r / 24, nb = r % 24; tr_item(w.uq, 768, 256, kb * 64, nb * 32, WB + WO_UQ, nb * 32, scr, lane); continue; } r -= I_UQ;
        if (r < I_UKV) { const int kb = r / 32, nb = r % 32; tr_item(w.ukv, 1024, 128, kb * 64, nb * 32, WB + WO_UKV, nb * 32, scr, lane); continue; } r -= I_UKV;
        if (r < 3 * I_BR) { const int bi = r / I_BR, q = r % I_BR, kb = q / 32, nb = q % 32; tr_item(w.br + (size_t)bi * 512 * 1024, DM, 512, kb * 64, nb * 32, WB + WO_BR + (size_t)bi * 1024 * 512, nb * 32, scr, lane); continue; } r -= 3 * I_BR;
        { const int kb = r / 32, nb = r % 32; tr_item(w.wout, DM, DM, kb * 64, nb * 32, WB + WO_OUT, nb * 32, scr, lane); }
    }
    { unsigned zz = 0u; asm volatile("" : "+v"(zz));
      for (int i = c.bid * 512 + tid; i < 96 * 1024 / 8; i += c.G * 512) ((u32x4*)(WB + WO_IN + (size_t)2720 * 1024))[i] = (u32x4){zz, zz, zz, zz}; }
}

template <int MODE>
__device__ __forceinline__ void norm_rows(const Ctx& c, const float* xp, const float* xs, float* xbuf, const float* g, bf16_t* XN) {
    LOCAL_TID
    const f32x4* g4 = (const f32x4*)g + lane;
    f32x4 gv[4];
#pragma unroll
    for (int j = 0; j < 4; ++j) gv[j] = g4[64 * j];
    constexpr int RB = 4;
    for (int m0 = CTX_GW(c); m0 < MT; m0 += RB * CTX_NGW(c)) {
        f32x4 v[RB][4];
#pragma unroll
        for (int q = 0; q < RB; ++q) { const int m = m0 + q * CTX_NGW(c); if (m < MT) {
            const float* src = (MODE == 1) ? (m < MP ? xp + (size_t)m * DM : xs + (size_t)(m - MP) * DM) : xbuf + (size_t)m * DM;
            const f32x4* xr = (const f32x4*)src + lane;
#pragma unroll
            for (int j = 0; j < 4; ++j) v[q][j] = xr[64 * j]; } }
#pragma unroll
        for (int q = 0; q < RB; ++q) { const int m = m0 + q * CTX_NGW(c); if (m < MT) {
            float s = 0.f;
#pragma unroll
            for (int j = 0; j < 4; ++j) s += (v[q][j].x * v[q][j].x + v[q][j].y * v[q][j].y) + (v[q][j].z * v[q][j].z + v[q][j].w * v[q][j].w);
            const float rstd = __builtin_amdgcn_rsqf(wave_sum(s, lane) * (1.f / DM) + EPS);
            if (MODE == 2) { f32x4* xo = (f32x4*)(xbuf + (size_t)m * DM) + lane;
#pragma unroll
                for (int j = 0; j < 4; ++j) xo[64 * j] = v[q][j] * rstd * gv[j]; }
            else { u32x2* o8 = (u32x2*)(XN + (size_t)m * DM) + lane;
#pragma unroll
                for (int j = 0; j < 4; ++j) { const f32x4 y = v[q][j] * rstd * gv[j]; u32x2 w; w.x = pk2(y.x, y.y); w.y = pk2(y.z, y.w); o8[64 * j] = w; } } } }
    }
}

__device__ __forceinline__ void misc_tables(const Ctx& c, unsigned char* ws, const float* w1, const float* b1, const float* w2, const float* b2, const float* freq) {
    LOCAL_TID
    f32x2* T2 = (f32x2*)(ws + WS_T2); f32x2* tabA = (f32x2*)(ws + WS_TABA); f32x2* tabM = (f32x2*)(ws + WS_TABM);
    const int gt = c.bid * 512 + tid, NT = c.G * 512;
    for (int j = gt; j < 8192; j += NT) { const float a = (float)j * (1.0f / 8192.0f); T2[j] = (f32x2){cospif(a), -sinpif(a)}; }
    for (int i = gt; i < 128 * 16; i += NT) { const int pos = i >> 4, f = i & 15; const float inv = powf(10000.0f, -(float)f / 16.0f); const float a = (float)pos * inv; tabA[i] = (f32x2){cosf(a), sinf(a)}; }
    for (int i = gt; i < 128 * 8; i += NT) { const int pos = i >> 3, f = i & 7; const float inv = powf(10000.0f, -(float)f / 8.0f); const float a = (float)pos * inv; tabM[i] = (f32x2){cosf(a), sinf(a)}; }
    for (int r = CTX_GW(c); r < 2 * 12288; r += CTX_NGW(c)) {
        const int l = r / 12288, q = r % 12288; const int L = q < 8192 ? 8192 : 4096; const int t = q < 8192 ? q : q - 8192;
        float* H2 = (float*)(ws + WS_H2 + (size_t)l * 3 * MiB) + (q < 8192 ? 0 : 8192 * 64) + (size_t)t * 64;
        const float tl = (float)t / (float)(L - 1); const float wv = 6.283185307179586f * (float)t / (float)L;
        float z = 0.f;
        if (lane == 0) z = tl;
        else if (lane < 33) { const int k = (lane - 1) & 15; const float f = 1e-4f + (float)k * ((15.0f - 1e-4f) / 15.0f); z = lane < 17 ? cosf(f * wv) : -sinf(f * wv); }
        const float* W1 = w1 + l * 33 * 64; const float* W2 = w2 + l * 64 * 64; const float fr = freq[l * 64 + lane];
        float a = b1[l * 64 + lane];
#pragma unroll
        for (int i = 0; i < 33; ++i) a += bcast_l(z, i) * W1[i * 64 + lane];
        const float h1 = sinf(fr * a);
        float a2 = b2[l * 64 + lane];
#pragma unroll 8
        for (int k = 0; k < 64; ++k) a2 += bcast_l(h1, k) * W2[k * 64 + lane];
        H2[lane] = sinf(fr * a2);
    }
}

__device__ __forceinline__ void tok_local(const Ctx& c, bf16_t* ZC, const float* gq, const float* gk, const float* gmq, const float* gmkv, const f32x2* tabA, const f32x2* tabM) {
    LOCAL_TID
    constexpr int RB = 4;
    for (int m0 = CTX_GW(c); m0 < MT; m0 += RB * CTX_NGW(c)) {
        unsigned raw[RB][9];
#pragma unroll
        for (int q = 0; q < RB; ++q) { const int m = m0 + q * CTX_NGW(c); if (m < MT) { const unsigned* zr = (const unsigned*)(ZC + (size_t)m * ZCW);
#pragma unroll
            for (int it = 0; it < 5; ++it) raw[q][it] = zr[it * 64 + lane];
            raw[q][5] = zr[C_CQ / 2 + lane]; raw[q][6] = zr[C_CQ / 2 + 64 + lane]; raw[q][7] = zr[C_CKV / 2 + lane]; raw[q][8] = zr[C_KR / 2 + (lane & 15)]; } }
#pragma unroll
        for (int q = 0; q < RB; ++q) { const int m = m0 + q * CTX_NGW(c); if (m < MT) {
        unsigned* zr = (unsigned*)(ZC + (size_t)m * ZCW); const int t = m < MP ? (m & (LP - 1)) : (m & (LS - 1));
#pragma unroll
        for (int it = 0; it < 5; ++it) { const int pidx = it * 64 + lane, head = pidx >> 5, pi = pidx & 31;
            const unsigned rw = raw[q][it]; const float x0 = bf2f(rw & 0xffffu), x1 = bf2f(rw >> 16);
            float ss = x0 * x0 + x1 * x1;
#pragma unroll
            for (int o = 1; o < 32; o <<= 1) ss += shfl_xor_l(ss, o, lane);
            const float r = __builtin_amdgcn_rsqf(ss * (1.f / 64.f) + EPS); const float* g = head < 8 ? gq : gk;
            const float n0 = x0 * r * g[2 * pi], n1 = x1 * r * g[2 * pi + 1];
            const int pos = pi < 16 ? (t >> 6) : (t & 63); const f32x2 cs = tabA[pos * 16 + (pi & 15)];
            zr[pidx] = pk2(n0 * cs.x - n1 * cs.y, n0 * cs.y + n1 * cs.x); }
        { const unsigned r0 = raw[q][5], r1 = raw[q][6];
          const float a0 = bf2f(r0 & 0xffffu), a1 = bf2f(r0 >> 16), b0 = bf2f(r1 & 0xffffu), b1 = bf2f(r1 >> 16);
          const float r = __builtin_amdgcn_rsqf(wave_sum(a0 * a0 + a1 * a1 + b0 * b0 + b1 * b1, lane) * (1.f / 256.f) + EPS);
          zr[C_CQ / 2 + lane] = pk2(a0 * r * gmq[2 * lane], a1 * r * gmq[2 * lane + 1]); zr[C_CQ / 2 + 64 + lane] = pk2(b0 * r * gmq[128 + 2 * lane], b1 * r * gmq[128 + 2 * lane + 1]); }
        { const unsigned r0 = raw[q][7]; const float a0 = bf2f(r0 & 0xffffu), a1 = bf2f(r0 >> 16);
          const float r = __builtin_amdgcn_rsqf(wave_sum(a0 * a0 + a1 * a1, lane) * (1.f / 128.f) + EPS);
          zr[C_CKV / 2 + lane] = pk2(a0 * r * gmkv[2 * lane], a1 * r * gmkv[2 * lane + 1]); }
        if (lane < 16) { const unsigned r0 = raw[q][8]; const float x0 = bf2f(r0 & 0xffffu), x1 = bf2f(r0 >> 16);
          const int pos = lane < 8 ? (t >> 6) : (t & 63); const f32x2 cs = tabM[pos * 8 + (lane & 7)];
          zr[C_KR / 2 + lane] = pk2(x0 * cs.x - x1 * cs.y, x0 * cs.y + x1 * cs.x); }
        } }
    }
}

__device__ __forceinline__ void short_conv8(const bf16_t* ZC, int m, int t, int L, int col, const float* wsh, const float* bsh, int hc, float* out) {
    const u32x4 zc = *(const u32x4*)(ZC + (size_t)m * ZCW + col);
    u32x4 zm = {0u, 0u, 0u, 0u}, zp = {0u, 0u, 0u, 0u};
    if (t > 0) zm = *(const u32x4*)(ZC + (size_t)(m - 1) * ZCW + col);
    if (t < L - 1) zp = *(const u32x4*)(ZC + (size_t)(m + 1) * ZCW + col);
#pragma unroll
    for (int e = 0; e < 8; ++e) { const unsigned a = zm[e >> 1], b = zc[e >> 1], d = zp[e >> 1];
        const float xm = (e & 1) ? __uint_as_float(a & 0xffff0000u) : __uint_as_float(a << 16);
        const float xc = (e & 1) ? __uint_as_float(b & 0xffff0000u) : __uint_as_float(b << 16);
        const float xp = (e & 1) ? __uint_as_float(d & 0xffff0000u) : __uint_as_float(d << 16);
        out[e] = xm * wsh[hc + e] + xc * wsh[1536 + hc + e] + xp * wsh[3072 + hc + e] + bsh[hc + e]; }
}
__device__ __forceinline__ void hy_fwd_tiles(const Ctx& c, const bf16_t* ZC, bf16_t* ST, const float* wsh, const float* bsh, LAS unsigned char* lds) {
    LOCAL_TID
    LAS bf16_t* T = (LAS bf16_t*)lds;
    const int tt = tid >> 3, cgp = tid & 7;
    for (int tile = c.bid; tile < (MT / 256) * 8; tile += c.G) {
        const int c0 = (tile & 7) * 64, mb = (tile >> 3) * 256; const int L = mb < MP ? LP : LS; const int ch = c0 + cgp * 8;
#pragma unroll
        for (int q = 0; q < 4; ++q) { const int m0 = mb + q * 64, t0 = m0 & (L - 1); const int m = m0 + tt, t = t0 + tt;
            float a[8], b[8];
            short_conv8(ZC, m, t, L, C_HY + 512 + ch, wsh, bsh, 512 + ch, a);
            short_conv8(ZC, m, t, L, C_HY + 1024 + ch, wsh, bsh, 1024 + ch, b);
#pragma unroll
            for (int e = 0; e < 8; ++e) T[q * 4608 + (cgp * 8 + e) * 72 + tt] = (bf16_t)f2bf(a[e] * b[e]); }
        __syncthreads();
#pragma unroll
        for (int q = 0; q < 4; ++q) { const int m0 = mb + q * 64, t0 = m0 & (L - 1), rb = m0 - t0; const int cl = tid >> 3, tch = tid & 7;
            const u32x4 v = *(const LAS u32x4*)(T + q * 4608 + cl * 72 + tch * 8);
            *(u32x4*)(ST + (size_t)rb * 512 + (size_t)(c0 + cl) * L + t0 + tch * 8) = v; }
        __syncthreads();
    }
}
__device__ __forceinline__ void hy_bwd_tiles(const Ctx& c, bf16_t* ZC, const bf16_t* ST, const float* wsh, const float* bsh, LAS unsigned char* lds) {
    LOCAL_TID
    LAS bf16_t* T = (LAS bf16_t*)lds;
    const int tt = tid >> 3, cgp = tid & 7;
    for (int tile = c.bid; tile < (MT / 256) * 8; tile += c.G) {
        const int c0 = (tile & 7) * 64, mb = (tile >> 3) * 256; const int L = mb < MP ? LP : LS; const int ch = c0 + cgp * 8;
#pragma unroll
        for (int q = 0; q < 4; ++q) { const int m0 = mb + q * 64, t0 = m0 & (L - 1), rb = m0 - t0; const int cl = tid >> 3, tch = tid & 7;
            const u32x4 v = *(const u32x4*)(ST + (size_t)rb * 512 + (size_t)(c0 + cl) * L + t0 + tch * 8);
            *(LAS u32x4*)(T + q * 4608 + cl * 72 + tch * 8) = v; }
        __syncthreads();
#pragma unroll
        for (int q = 0; q < 4; ++q) { const int m0 = mb + q * 64, t0 = m0 & (L - 1); const int m = m0 + tt, t = t0 + tt;
            float a[8];
            short_conv8(ZC, m, t, L, C_HY + ch, wsh, bsh, ch, a);
            float r[8];
#pragma unroll
            for (int e = 0; e < 8; ++e) r[e] = a[e] * bf2f(T[q * 4608 + (cgp * 8 + e) * 72 + tt]);
            u32x4 w; w.x = pk2(r[0], r[1]); w.y = pk2(r[2], r[3]); w.z = pk2(r[4], r[5]); w.w = pk2(r[6], r[7]);
            *(u32x4*)(ZC + (size_t)m * ZCW + C_YB + ch) = w; }
        __syncthreads();
    }
}

__device__ __forceinline__ float fadd_(float a, float b) { float r; asm("v_add_f32_e32 %0, %1, %2" : "=v"(r) : "v"(a), "v"(b)); return r; }
__device__ __forceinline__ float fsub_(float a, float b) { float r; asm("v_sub_f32_e32 %0, %1, %2" : "=v"(r) : "v"(a), "v"(b)); return r; }
__device__ __forceinline__ float fmul_(float a, float b) { float r; asm("v_mul_f32_e32 %0, %1, %2" : "=v"(r) : "v"(a), "v"(b)); return r; }
__device__ __forceinline__ float ffma_(float a, float b, float c) { float r; asm("v_fma_f32 %0, %1, %2, %3" : "=v"(r) : "v"(a), "v"(b), "v"(c)); return r; }
__device__ __forceinline__ float fnma_(float a, float b, float c) { float r; asm("v_fma_f32 %0, -%1, %2, %3" : "=v"(r) : "v"(a), "v"(b), "v"(c)); return r; }
__device__ __forceinline__ f32x2 cadd(f32x2 a, f32x2 b) { return (f32x2){fadd_(a.x, b.x), fadd_(a.y, b.y)}; }
__device__ __forceinline__ f32x2 csub(f32x2 a, f32x2 b) { return (f32x2){fsub_(a.x, b.x), fsub_(a.y, b.y)}; }
__device__ __forceinline__ f32x2 cscale(f32x2 a, float s) { return (f32x2){fmul_(a.x, s), fmul_(a.y, s)}; }
__device__ __forceinline__ f32x2 cmul(f32x2 a, f32x2 b) { return (f32x2){fnma_(a.y, b.y, fmul_(a.x, b.x)), ffma_(a.y, b.x, fmul_(a.x, b.y))}; }
__device__ __forceinline__ f32x2 cmulc(f32x2 a, f32x2 b) { return (f32x2){ffma_(a.y, b.y, fmul_(a.x, b.x)), fnma_(a.x, b.y, fmul_(a.y, b.x))}; }
__device__ __forceinline__ int PADI(int i) { return i + (i >> 4); }
__device__ __forceinline__ constexpr float c16f(int m) { return m == 0 ? 1.f : m == 1 ? 0.92387953251128674f : m == 2 ? 0.70710678118654752f : m == 3 ? 0.38268343236508977f : m == 4 ? 0.f : m == 5 ? -0.38268343236508977f : m == 6 ? -0.70710678118654752f : -0.92387953251128674f; }
__device__ __forceinline__ constexpr float s16f(int m) { return m == 0 ? 0.f : m == 1 ? 0.38268343236508977f : m == 2 ? 0.70710678118654752f : m == 3 ? 0.92387953251128674f : m == 4 ? 1.f : m == 5 ? 0.92387953251128674f : m == 6 ? 0.70710678118654752f : 0.38268343236508977f; }
#define CW16(m) ((f32x2){(m) == 0 ? 1.f : (m) == 1 ? k1 : (m) == 2 ? k2 : (m) == 3 ? k3 : (m) == 4 ? 0.f : (m) == 5 ? -k3 : (m) == 6 ? -k2 : -k1, (m) == 0 ? 0.f : (m) == 1 ? -k3 : (m) == 2 ? -k2 : (m) == 3 ? -k1 : (m) == 4 ? -1.f : (m) == 5 ? -k1 : (m) == 6 ? -k2 : -k3})
template <int R, bool UNIT> __device__ __forceinline__ void dif_regs(f32x2* v, f32x2 wb) {
    float k1 = 0.92387953251128674f, k2 = 0.70710678118654752f, k3 = 0.38268343236508977f; asm volatile("" : "+v"(k1), "+v"(k2), "+v"(k3));
#pragma unroll
    for (int t = 0; t < R; ++t) { constexpr int dummy = 0; (void)dummy; const int half = 1 << (R - 1 - t);
#pragma unroll
        for (int k = 0; k < (1 << R); ++k) if (!(k & half)) { const int kk = k & (half - 1), m = kk * (8 / half);
            const f32x2 a = v[k], b = v[k + half]; v[k] = cadd(a, b); const f32x2 d = csub(a, b);
            if (UNIT) { v[k + half] = (m == 0) ? d : (m == 4) ? (f32x2){d.y, -d.x} : cmul(d, CW16(m)); }
            else { const f32x2 tw = (m == 0) ? wb : cmul(wb, CW16(m)); v[k + half] = cmul(d, tw); } }
        if (!UNIT) wb = cmul(wb, wb); }
}
template <int R, bool UNIT> __device__ __forceinline__ void dit_regs(f32x2* v, f32x2 wbig) {
    float k1 = 0.92387953251128674f, k2 = 0.70710678118654752f, k3 = 0.38268343236508977f; asm volatile("" : "+v"(k1), "+v"(k2), "+v"(k3));
    f32x2 wbs[R]; wbs[R - 1] = wbig;
#pragma unroll
    for (int t = R - 2; t >= 0; --t) wbs[t] = cmul(wbs[t + 1], wbs[t + 1]);
#pragma unroll
    for (int t = 0; t < R; ++t) { const int half = 1 << t;
#pragma unroll
        for (int k = 0; k < (1 << R); ++k) if (!(k & half)) { const int kk = k & (half - 1), m = kk * (8 / half);
            const f32x2 a = v[k]; f32x2 b = v[k + half];
            if (UNIT) { if (m == 4) b = (f32x2){-b.y, b.x}; else if (m != 0) b = cmulc(b, CW16(m)); }
            else { const f32x2 tw = (m == 0) ? wbs[t] : cmul(wbs[t], CW16(m)); b = cmulc(b, tw); }
            v[k] = cadd(a, b); v[k + half] = csub(a, b); } }
}
template <int R> __device__ __forceinline__ void dif_pass_rt(LAS f32x2* X, int sl, const f32x2 wb_in, int tid) {
    float wbx = wb_in.x, wby = wb_in.y; asm volatile("" : "+v"(wbx), "+v"(wby)); const f32x2 wb = {wbx, wby};
    const int r = tid & ((1 << sl) - 1), base = ((tid >> sl) << (sl + R)) + r;
    LAS f32x2* Xb = X + PADI(base); f32x2 v[1 << R];
#pragma unroll
    for (int k = 0; k < (1 << R); ++k) v[k] = Xb[(k << sl) + ((k << sl) >> 4)];
    dif_regs<R, false>(v, wb);
#pragma unroll
    for (int k = 0; k < (1 << R); ++k) Xb[(k << sl) + ((k << sl) >> 4)] = v[k];
}
template <int R> __device__ __forceinline__ void dit_pass_rt(LAS f32x2* X, int sl, const f32x2 wb_in, int tid) {
    float wbx = wb_in.x, wby = wb_in.y; asm volatile("" : "+v"(wbx), "+v"(wby)); const f32x2 wbig = {wbx, wby};
    const int r = tid & ((1 << sl) - 1), base = ((tid >> sl) << (sl + R)) + r;
    LAS f32x2* Xb = X + PADI(base); f32x2 v[1 << R];
#pragma unroll
    for (int k = 0; k < (1 << R); ++k) v[k] = Xb[(k << sl) + ((k << sl) >> 4)];
    dit_regs<R, false>(v, wbig);
#pragma unroll
    for (int k = 0; k < (1 << R); ++k) Xb[(k << sl) + ((k << sl) >> 4)] = v[k];
}
template <int NPT> __device__ __forceinline__ int pass_sl(int ps) { return NPT == 16 ? (ps == 0 ? 9 : ps == 1 ? 5 : 1) : (ps == 0 ? 9 : ps == 1 ? 6 : 3); }
template <int NPT> __device__ __forceinline__ void fwd2_to_lds(LAS f32x2* Xe, LAS f32x2* Xo, const f32x2* tw, int tid, f32x2* ve, f32x2* vo) {
    constexpr int R = NPT == 16 ? 4 : 3;
    asm volatile("" : "+v"(tid)); __syncthreads();
    { LAS f32x2* Pe = Xe + PADI(tid); LAS f32x2* Po = Xo + PADI(tid);
#pragma unroll
      for (int k = 0; k < NPT; ++k) { Pe[544 * k] = ve[k]; Po[544 * k] = vo[k]; } }
    __syncthreads();
#pragma nounroll
    for (int ps = 0; ps < 3; ++ps) { int sl = pass_sl<NPT>(ps); asm volatile("" : "+s"(sl));
        const f32x2 wb = tw[(tid & ((1 << sl) - 1)) << (14 - R - sl)];
        dif_pass_rt<R>(Xe, sl, wb, tid); dif_pass_rt<R>(Xo, sl, wb, tid); __syncthreads(); }
}
template <int NPT> __device__ __forceinline__ void mid_spectrum(const LAS f32x2* X, int tid, f32x2* K, float sc) {
    if (NPT == 16) {
#pragma unroll
        for (int u = 0; u < 8; ++u) { const LAS f32x2* Xb = X + PADI(2 * tid) + 1088 * u; const f32x2 a = Xb[0], b = Xb[1]; K[2 * u] = cscale(cadd(a, b), sc); K[2 * u + 1] = cscale(csub(a, b), sc); } }
    else { f32x2 w[8]; const LAS f32x2* Xb = X + PADI(8 * tid);
#pragma unroll
        for (int k = 0; k < 8; ++k) w[k] = Xb[k];
        dif_regs<3, true>(w, (f32x2){1.f, 0.f});
#pragma unroll
        for (int k = 0; k < 8; ++k) K[k] = cscale(w[k], sc); }
}
template <int NPT> __device__ __forceinline__ void mid_mul(LAS f32x2* X, int tid, const f32x2* K) {
    if (NPT == 16) {
#pragma unroll
        for (int u = 0; u < 8; ++u) { LAS f32x2* Xb = X + PADI(2 * tid) + 1088 * u; const f32x2 a = Xb[0], b = Xb[1];
            const f32x2 s = cmul(cadd(a, b), K[2 * u]), d = cmul(csub(a, b), K[2 * u + 1]); Xb[0] = cadd(s, d); Xb[1] = csub(s, d); } }
    else { f32x2 w[8]; LAS f32x2* Xb = X + PADI(8 * tid);
#pragma unroll
        for (int k = 0; k < 8; ++k) w[k] = Xb[k];
        dif_regs<3, true>(w, (f32x2){1.f, 0.f});
#pragma unroll
        for (int k = 0; k < 8; ++k) w[k] = cmul(w[k], K[k]);
        dit_regs<3, true>(w, (f32x2){1.f, 0.f});
#pragma unroll
        for (int k = 0; k < 8; ++k) Xb[k] = w[k]; }
}
template <int NPT> __device__ __forceinline__ void conv2(LAS f32x2* Xe, LAS f32x2* Xo, const f32x2* tw, int tid, f32x2* ve, f32x2* vo, const f32x2* KE, const f32x2* KO) {
    fwd2_to_lds<NPT>(Xe, Xo, tw, tid, ve, vo);
    mid_mul<NPT>(Xe, tid, KE); mid_mul<NPT>(Xo, tid, KO);
    __syncthreads();
    constexpr int R = NPT == 16 ? 4 : 3;
#pragma nounroll
    for (int ps = 2; ps >= 0; --ps) { int sl = pass_sl<NPT>(ps); asm volatile("" : "+s"(sl));
        const f32x2 wb = tw[(tid & ((1 << sl) - 1)) << (14 - R - sl)];
        dit_pass_rt<R>(Xe, sl, wb, tid); dit_pass_rt<R>(Xo, sl, wb, tid); __syncthreads(); }
    { const LAS f32x2* Pe = Xe + PADI(tid); const LAS f32x2* Po = Xo + PADI(tid);
#pragma unroll
      for (int k = 0; k < NPT; ++k) { ve[k] = Pe[544 * k]; vo[k] = Po[544 * k]; } }
}
template <int NPT>
__device__ __forceinline__ void hyena_unit(LAS unsigned char* lds, int ch, int rowbase, int nb, const float* H2, const float* w3, const float* bias, bf16_t* ST, const f32x2* T2, int tid_in) {
    constexpr int N = 512 * NPT; int tid = tid_in; asm volatile("" : "+v"(tid));
    LAS f32x2* Xe = (LAS f32x2*)lds; LAS f32x2* Xo = (LAS f32x2*)(lds + 69632); LAS float* wsm = (LAS float*)(lds + 139264);
    __syncthreads();
    if (tid < 128) wsm[tid] = w3[(tid & 63) * 1024 + (tid >> 6) * 512 + ch];
    __syncthreads();
    LAS float* FW = (LAS float*)Xe; LAS float* BW = FW + N;
    const float dmin = -3.0701134573253945f, dmax = -15.350567286626973f;
    const float delta = fabsf(dmin + (float)ch * ((dmax - dmin) / 511.0f));
    const float bs = bias[ch];
    {
      const int lane = tid & 63, wv = tid >> 6, qs = lane & 3, rr = lane >> 2;
      float wf[16], wb[16];
#pragma unroll
      for (int s4 = 0; s4 < 4; ++s4)
#pragma unroll
          for (int e = 0; e < 4; ++e) { wf[s4 * 4 + e] = wsm[4 * (qs + 4 * s4) + e]; wb[s4 * 4 + e] = wsm[64 + 4 * (qs + 4 * s4) + e]; }
      const float tsc = -delta / (float)(N - 1);
#pragma unroll 2
      for (int it = 0; it < N / 128; ++it) { const int t = wv * (N / 8) + it * 16 + rr; const f32x4* hp = (const f32x4*)(H2 + (size_t)t * 64) + qs; float af = 0.f, ab = 0.f;
#pragma unroll
          for (int s4 = 0; s4 < 4; ++s4) { const f32x4 h = hp[4 * s4];
              af = ffma_(h.x, wf[s4 * 4], af); af = ffma_(h.y, wf[s4 * 4 + 1], af); af = ffma_(h.z, wf[s4 * 4 + 2], af); af = ffma_(h.w, wf[s4 * 4 + 3], af);
              ab = ffma_(h.x, wb[s4 * 4], ab); ab = ffma_(h.y, wb[s4 * 4 + 1], ab); ab = ffma_(h.z, wb[s4 * 4 + 2], ab); ab = ffma_(h.w, wb[s4 * 4 + 3], ab); }
          af += shfl_xor_l(af, 1, lane); ab += shfl_xor_l(ab, 1, lane); af += shfl_xor_l(af, 2, lane); ab += shfl_xor_l(ab, 2, lane);
          if (qs == 0) { const float win = expf((float)t * tsc); FW[t] = af * win + (t == 0 ? bs : 0.f); BW[t] = ab * win; } } }
    __syncthreads();
    f32x2 KE[NPT], KO[NPT];
    const f32x2* tw = T2;
    const float sc = 1.0f / (2.0f * (float)N);
    { f32x2 ve[NPT], vo[NPT];
#pragma unroll
      for (int i = 0; i < NPT; ++i) { const int j = tid + 512 * i; const float fr = FW[j], br = (j == 0) ? 0.f : BW[N - j]; const f32x2 w = T2[j * (8192 / N)]; const float d = fr - br;
          ve[i] = (f32x2){fadd_(fr, br), 0.f}; vo[i] = cscale(w, d); }
      fwd2_to_lds<NPT>(Xe, Xo, tw, tid, ve, vo);
      mid_spectrum<NPT>(Xe, tid, KE, sc); mid_spectrum<NPT>(Xo, tid, KO, sc); }
    for (int p = 0; p < nb / 2; ++p) {
        bf16_t* s0 = ST + (size_t)(rowbase + 2 * p * N) * 512 + (size_t)ch * N; bf16_t* s1 = s0 + (size_t)N * 512;
        f32x2 ve[NPT], vo[NPT];
#pragma unroll
        for (int i = 0; i < NPT; ++i) { const int j = tid + 512 * i; ve[i] = (f32x2){bf2f(s0[j]), bf2f(s1[j])}; vo[i] = cmul(ve[i], T2[j * (8192 / N)]); }
        conv2<NPT>(Xe, Xo, tw, tid, ve, vo, KE, KO);
#pragma unroll
        for (int i = 0; i < NPT; ++i) { const int j = tid + 512 * i; const f32x2 y = cadd(ve[i], cmulc(vo[i], T2[j * (8192 / N)]));
            s0[j] = (bf16_t)f2bf(y.x); s1[j] = (bf16_t)f2bf(y.y); }
    }
    __syncthreads();
}

#define XB_TMO      128
#define XB_XCNT(j)  (256  + 64 * (j))
#define XB_XSUB(j)  (1280 + 64 * (j))
#define XB_XGEN(j)  (2304 + 64 * (j))
#define XB_TOP      3328
#define XB_TOPGEN   3392
#define XCD_BAR_WORDS 3456
#define XB_SPIN_CAP (1u << 18)

__device__ __forceinline__ unsigned xb_ld(unsigned* p)              { return __hip_atomic_load(p, __ATOMIC_RELAXED, __HIP_MEMORY_SCOPE_AGENT); }
__device__ __forceinline__ unsigned xb_add(unsigned* p, unsigned v) { return __hip_atomic_fetch_add(p, v, __ATOMIC_RELAXED, __HIP_MEMORY_SCOPE_AGENT); }
__device__ __forceinline__ unsigned xb_xcc_id() { return (unsigned)__builtin_amdgcn_s_getreg((3 << 11) | 20) & 0xFu; }
#define XB_SPIN(cond, bar) do { unsigned _sp = 0; while (cond) { __builtin_amdgcn_s_sleep(1); \
    if ((++_sp & 255u) == 0u) { if (xb_ld(&(bar)[XB_TMO])) break; if (_sp > XB_SPIN_CAP) { atomicAdd(&(bar)[XB_TMO], 1u); break; } } } } while (0)

struct XcdBarrier {
    unsigned* bar; unsigned x; int w;
    volatile LAS unsigned* st;
};

__device__ __forceinline__ XcdBarrier xcd_barrier_post(unsigned* bar, volatile LAS unsigned* st) {
    XcdBarrier b; b.bar = bar; b.x = xb_xcc_id(); b.st = st; b.w = __builtin_amdgcn_readfirstlane((int)threadIdx.x >> 6);
    if (threadIdx.x == 0) (void)xb_add(&bar[XB_XCNT(b.x)], 1u);
    return b;
}
__device__ __forceinline__ void xcd_barrier_complete(unsigned* bar, unsigned x, unsigned& nloc, unsigned& nx) {
    const unsigned G = gridDim.x * gridDim.y * gridDim.z;
    unsigned sum, cnt, mine, sp = 0u;
    for (;;) {
        sum = 0u; cnt = 0u; mine = 0u;
#pragma unroll
        for (unsigned j = 0; j < 16; ++j) { const unsigned c = xb_ld(&bar[XB_XCNT(j)]); sum += c; cnt += (c > 0u) ? 1u : 0u; mine = (j == x) ? c : mine; }
        if (sum == G) break;
        __builtin_amdgcn_s_sleep(1);
        if ((++sp & 255u) == 0u) { if (xb_ld(&bar[XB_TMO])) break; if (sp > XB_SPIN_CAP) { atomicAdd(&bar[XB_TMO], 1u); break; } }
    }
    nloc = mine > 0u ? mine : 1u; nx = cnt > 0u ? cnt : 1u;
}

__device__ __forceinline__ void xcd_barrier_census(const XcdBarrier& b) {
    if (b.w == 0 && fresh_lane() == 0) { unsigned nloc, nx; xcd_barrier_complete(b.bar, b.x, nloc, nx); b.st[0] = nloc; b.st[1] = nx; }
    __syncthreads();
}
__device__ __forceinline__ void xcd_barrier(const XcdBarrier& b) {
    asm volatile("s_waitcnt vmcnt(0)" ::: "memory");
    __syncthreads();
    if (b.w == 0 && fresh_lane() == 0) {
        unsigned* bar = b.bar;
        __builtin_amdgcn_s_waitcnt(0);
        unsigned nloc = b.st[0], nx = b.st[1];
        const unsigned old = xb_add(&bar[XB_XSUB(b.x)], 1u);
        const unsigned gen = old / nloc;
        if (old + 1u == (gen + 1u) * nloc) {
            __builtin_amdgcn_fence(__ATOMIC_RELEASE, "agent");
            asm volatile("s_waitcnt vmcnt(0)" ::: "memory");
            const unsigned og = xb_add(&bar[XB_TOP], 1u);
            const unsigned tg = og / nx;
            if (og + 1u == (tg + 1u) * nx) xb_add(&bar[XB_TOPGEN], 1u);
            else XB_SPIN(xb_ld(&bar[XB_TOPGEN]) == tg, bar);
            __builtin_amdgcn_fence(__ATOMIC_ACQUIRE, "agent");
            xb_add(&bar[XB_XGEN(b.x)], 1u);
            asm volatile("s_waitcnt vmcnt(0)" ::: "memory");
        } else {
            XB_SPIN(xb_ld(&bar[XB_XGEN(b.x)]) == gen, bar);
            __builtin_amdgcn_fence(__ATOMIC_ACQUIRE, "agent");
            asm volatile("s_waitcnt vmcnt(0)" ::: "memory");
        }
    }
    __syncthreads();
}


#ifndef PROBE_SKIP
#define PROBE_SKIP 0
#endif
constexpr int NPASS = PROBE_SKIP ? 2 : 1;
#define DO(bit) (pass == NPASS - 1 || !(PROBE_SKIP & (bit)))
struct Params { const float* in[30]; float* out; unsigned char* ws; };

__global__ void __launch_bounds__(512, 2) mk_fwd(Params p) {
    extern __shared__ __attribute__((aligned(16))) unsigned char lds_raw[];
    cg::grid_group grid = cg::this_grid();
    LAS unsigned char* lds = (LAS unsigned char*)lds_raw;
    Ctx c; c.wave = __builtin_amdgcn_readfirstlane((int)threadIdx.x >> 6); c.G = gridDim.x; c.bid = blockIdx.x;
    unsigned char* ws = p.ws; float* x = p.out;
    { volatile LAS unsigned* st = (volatile LAS unsigned*)(lds + LDS_BYTES - 16); if (threadIdx.x < 4) st[threadIdx.x] = 0u; }
    __syncthreads();
    const XcdBarrier xbar = xcd_barrier_post((unsigned*)(p.ws + WS_BAR), (volatile LAS unsigned*)(lds + LDS_BYTES - 16));
#define WB ((bf16_t*)(ws + WS_W))
#define XN ((bf16_t*)(ws + WS_XN))
#define BIG ((bf16_t*)(ws + WS_BIG))
#define ST ((bf16_t*)(ws + WS_ST))
#define QH ((bf16_t*)(ws + WS_QH))
#define KVH ((bf16_t*)(ws + WS_KVH))
#define MG ((bf16_t*)(ws + WS_MG))
#define PB ((bf16_t*)(ws + WS_PB))
#define T2 ((const f32x2*)(ws + WS_T2))
#define tabA ((const f32x2*)(ws + WS_TABA))
#define tabM ((const f32x2*)(ws + WS_TABM))
#define SSQ(i) ((float*)(ws + WS_W + WO_END * 2) + (size_t)(i) * MT)
#define LAUNDER() asm volatile("" : "+s"(c.bid), "+s"(c.G), "+s"(ws), "+s"(x))
#define SYNC() do { xcd_barrier(xbar); LAUNDER(); } while (0)
#define SYNC_CG() do { grid.sync(); LAUNDER(); } while (0)
    for (int pass = 0; pass < NPASS; ++pass) {
    misc_tables(c, ws, p.in[12], p.in[13], p.in[14], p.in[15], p.in[17]);

#define GEMMX(BIT, EPI, Aptr, LDA, Bptr, NN, KK, ...) do { if (!DO(BIT)) break; pg8::Gemm g_{(const bf16_t*)(Aptr), (const bf16_t*)(Bptr), MT, NN, KK, LDA}; pg8::StaticOrder S_; S_.init(MT, NN, c.G, c.bid); \
        EPI E_{__VA_ARGS__}; pg8::gemm_phase<EPI>(lds, g_, S_, E_, c.wave); } while (0)
#define GEMM(...) GEMMX(2, __VA_ARGS__)
#define GEMMF(...) GEMMX(16, __VA_ARGS__)

    for (int l = 0; l < 2; ++l) {
        LAUNDER();
        { LayerW w; w.gate1 = p.in[3] + (size_t)l * DM * DFF; w.up1 = p.in[4] + (size_t)l * DM * DFF; w.dn1 = p.in[5] + (size_t)l * DFF * DM; w.win = p.in[7] + (size_t)l * DM * 5792;
          w.uq = p.in[20] + (size_t)l * 256 * 768; w.ukv = p.in[22] + (size_t)l * 128 * 1024; w.br = p.in[23] + (size_t)l * 3 * 512 * 1024; w.wout = p.in[24] + (size_t)l * DM * DM;
          w.gate2 = p.in[26] + (size_t)l * DM * DFF; w.up2 = p.in[27] + (size_t)l * DM * DFF; w.dn2 = p.in[28] + (size_t)l * DFF * DM;
          if (DO(8)) convert_weights(c, w, WB, lds); }
        if (l == 0 && DO(8)) norm_rows<1>(c, p.in[0], p.in[1], x, p.in[2], XN);
        if (l == 0) { SYNC_CG(); xcd_barrier_census(xbar); } else SYNC();
        const float* ssA = l == 0 ? nullptr : SSQ(0);
        float* ssMix = SSQ(0); float* ssF2 = SSQ(0);
        GEMMF(pg8::EpiSwiglu, XN, DM, WB + WO_GU1, 5632, DM, BIG, DFF, ssA);
        SYNC();
        GEMMF(pg8::EpiResid<1>, BIG, DFF, WB + WO_DN1, DM, DFF, x, p.in[6] + l * DM, XN, ssMix, (LAS float*)(lds + 131072), l == 0 ? p.in[0] : nullptr, l == 0 ? p.in[1] : nullptr);
        SYNC();
        GEMM(pg8::EpiStore, XN, DM, WB + WO_IN, ZCW, DM, BIG, ZCW, ssMix);
        SYNC();
        if (DO(8)) tok_local(c, BIG, p.in[8] + l * 64, p.in[9] + l * 64, p.in[19] + l * 256, p.in[21] + l * 128, tabA, tabM);
        if (DO(8)) hy_fwd_tiles(c, BIG, ST, p.in[10] + (size_t)l * 3 * 1536, p.in[11] + l * 1536, lds);
        SYNC();
        GEMM(pg8::EpiStore, BIG + C_CQ, ZCW, WB + WO_UQ, 768, 256, QH, 768, nullptr);
        GEMM(pg8::EpiStore, BIG + C_CKV, ZCW, WB + WO_UKV, 1024, 128, KVH, 1024, nullptr);
        __syncthreads();
        { const float* H2l = (const float*)(ws + WS_H2 + (size_t)l * 3 * MiB); const float* w3 = p.in[16] + (size_t)l * 64 * 1024; const float* hb = p.in[18] + l * 512;
          if (DO(4)) for (int u = c.bid; u < 1024; u += c.G) {
              if (u < 512) hyena_unit<16>(lds, u, 0, 8, H2l, w3, hb, ST, T2, c.wave * 64 + fresh_lane());
              else hyena_unit<8>(lds, u - 512, MP, 4, H2l + 8192 * 64, w3, hb, ST, T2, c.wave * 64 + fresh_lane()); } }
        __syncthreads();
        if (DO(1)) for (int i = 0;; ++i) { const int u = i * c.G + CTX_VCU(c); if (u >= 2560) break;
            int rowbase, qb, h, L;
            if (u < 2048) { qb = u & 31; h = (u >> 5) & 7; rowbase = (u >> 8) * LP; L = LP; } else { const int v = u - 2048; qb = v & 15; h = (v >> 4) & 7; rowbase = MP + (v >> 7) * LS; L = LS; }
            bf16_t* Qb = BIG + (size_t)(rowbase + qb * 256) * ZCW + C_Q + h * 64; const bf16_t* Kb = BIG + (size_t)rowbase * ZCW + C_K + (h >> 2) * 64; const bf16_t* Vb = BIG + (size_t)rowbase * ZCW + C_V + (h >> 2) * 64;
            att::attn_unit<4>(Qb, ZCW, Kb, ZCW, nullptr, 0, Vb, ZCW, Qb, ZCW, L, (char*)lds_raw, 0, nullptr, c.wave); }
        SYNC();
        if (DO(1)) for (int i = 0;; ++i) { const int u = i * c.G + CTX_VCU(c); if (u >= 2560) break;
            int rowbase, qb, h, L;
            if (u < 2048) { qb = u & 31; h = (u >> 5) & 7; rowbase = (u >> 8) * LP; L = LP; } else { const int v = u - 2048; qb = v & 15; h = (v >> 4) & 7; rowbase = MP + (v >> 7) * LS; L = LS; }
            const bf16_t* Qb = QH + (size_t)(rowbase + qb * 256) * 768 + h * 96; const bf16_t* K1 = KVH + (size_t)rowbase * 1024 + h * 128; const bf16_t* K2 = BIG + (size_t)rowbase * ZCW + C_KR;
            const bf16_t* Vb = K1 + 64; bf16_t* Ob = BIG + (size_t)(rowbase + qb * 256) * ZCW + C_YC + h * 64;
            att::attn_unit<6>(Qb, 768, K1, 1024, K2, ZCW, Vb, 1024, Ob, ZCW, L, (char*)lds_raw, qb * 256, tabM, c.wave); }
        if (DO(8)) hy_bwd_tiles(c, BIG, ST, p.in[10] + (size_t)l * 3 * 1536, p.in[11] + l * 1536, lds);
        SYNC();
        GEMM(pg8::EpiStore, BIG + C_Q, ZCW, WB + WO_BR, DM, 512, MG, DM, nullptr);
        GEMM(pg8::EpiGate<0>, XN, DM, WB + WO_GATE, DM, DM, MG, MG, ssMix);
        GEMM(pg8::EpiStore, BIG + C_YB, ZCW, WB + WO_BR + (size_t)1024 * 512, DM, 512, PB, DM, nullptr);
        GEMM(pg8::EpiGate<1>, XN, DM, WB + WO_GATE + (size_t)1024 * 1024, DM, DM, MG, PB, ssMix);
        GEMM(pg8::EpiStore, BIG + C_YC, ZCW, WB + WO_BR + (size_t)2 * 1024 * 512, DM, 512, PB, DM, nullptr);
        GEMM(pg8::EpiGate<1>, XN, DM, WB + WO_GATE + (size_t)2 * 1024 * 1024, DM, DM, MG, PB, ssMix);
        SYNC();
        GEMM(pg8::EpiResid<0>, MG, DM, WB + WO_OUT, DM, DM, x, p.in[25] + l * DM, XN, ssF2, (LAS float*)(lds + 131072), nullptr, nullptr);
        SYNC();
        GEMMF(pg8::EpiSwiglu, XN, DM, WB + WO_GU2, 5632, DM, BIG, DFF, ssF2);
        SYNC();
        GEMMF(pg8::EpiResid<1>, BIG, DFF, WB + WO_DN2, DM, DFF, x, l == 0 ? p.in[2] + DM : nullptr, XN, SSQ(0), (LAS float*)(lds + 131072), nullptr, nullptr);
        SYNC();
    }
    norm_rows<2>(c, nullptr, nullptr, x, p.in[29], nullptr);
    if (pass + 1 < NPASS) SYNC();
    }
}

extern "C" void kernel_launch(void* const* d_in, const int* in_sizes, int n_in, void* d_out, int out_size, void* d_ws, size_t ws_size, hipStream_t stream) {
    static int grid = 0;
    if (grid == 0) {
        if (n_in != 30 || out_size != MT * DM || ws_size < WS_END) { fprintf(stderr, "kernel_launch: unexpected shapes: n_in %d out %d ws %zu\n", n_in, out_size, ws_size); grid = -1; return; }
        int dev = 0, cus = 0, per_cu = 0;
        hipGetDevice(&dev); hipDeviceGetAttribute(&cus, hipDeviceAttributeMultiprocessorCount, dev);
        if (hipFuncSetAttribute((const void*)mk_fwd, hipFuncAttributeMaxDynamicSharedMemorySize, LDS_BYTES) != hipSuccess) { fprintf(stderr, "kernel_launch: hipFuncSetAttribute failed\n"); grid = -1; return; }
        hipOccupancyMaxActiveBlocksPerMultiprocessor(&per_cu, (const void*)mk_fwd, 512, LDS_BYTES);
        if (per_cu < 1) { fprintf(stderr, "kernel_launch: occupancy query says %d\n", per_cu); per_cu = 1; }
        (void)hipGetLastError();
        grid = cus * 1;
    }
    if (grid < 0) return;
    if (hipMemsetAsync((char*)d_ws + WS_BAR, 0, 16384, stream) != hipSuccess) { fprintf(stderr, "kernel_launch: memset failed\n"); return; }
    Params p{};
    for (int i = 0; i < 30; ++i) p.in[i] = (const float*)d_in[i];
    p.out = (float*)d_out; p.ws = (unsigned char*)d_ws;
    void* args[] = {&p};
    hipError_t e = hipLaunchCooperativeKernel((const void*)mk_fwd, dim3(grid), dim3(512), args, LDS_BYTES, stream);
    if (e != hipSuccess) fprintf(stderr, "cooperative launch failed: %s (grid %d)\n", hipGetErrorString(e), grid);
}
```
